# Optimizing an MI355X kernel written in HIP

```python
import math
import jax, jax.numpy as jnp
from jax import lax
import numpy as np

D_MODEL = 1024
BATCH = 32
SEQ = 2048
DEPTH = 1

HEAD_DIM = 64
MIX_WIDTH = D_MODEL
ATTN_WIDTH = MIX_WIDTH // 2
FOURIER_WIDTH = MIX_WIDTH - ATTN_WIDTH
N_FOURIER_GROUPS = FOURIER_WIDTH // HEAD_DIM
N_Q_HEADS = ATTN_WIDTH // HEAD_DIM
Q_PER_KV = 4
N_KV_HEADS = N_Q_HEADS // Q_PER_KV
KV_WIDTH = N_KV_HEADS * HEAD_DIM
IN_PROJ_WIDTH = FOURIER_WIDTH + ATTN_WIDTH + 2 * KV_WIDTH
WINDOW = 128
BLOCK = 128
N_BUCKETS = 32
MAX_DISTANCE = 128
N_EXPERTS = 16
CAPACITY_FACTOR = 2
D_EXPERT = 1024
N_ADA = 6
EPS = 1e-6

kernel_name = "hybrid_fourier_window_gqa_ec_moe_block"


def rmsnorm(x, g):
    xf = x.astype(jnp.float32)
    y = xf * lax.rsqrt(jnp.mean(xf * xf, axis=-1, keepdims=True) + EPS)
    return (y * g.astype(jnp.float32)).astype(x.dtype)


def t5_bucket(rel):
    half = N_BUCKETS // 2
    max_exact = half // 2
    ret = jnp.where(rel > 0, half, 0)
    n = jnp.abs(rel)
    nf = jnp.maximum(n, 1).astype(jnp.float32)
    large = max_exact + (jnp.log(nf / max_exact) / math.log(MAX_DISTANCE / max_exact)
                         * (half - max_exact)).astype(jnp.int32)
    large = jnp.minimum(large, half - 1)
    return ret + jnp.where(n < max_exact, n, large)


def fourier_mix(u, w_f, b_f):
    B, S, _ = u.shape
    ug = u.reshape(B, S, N_FOURIER_GROUPS, HEAD_DIM).astype(jnp.float32)
    mixed = jnp.fft.fft2(ug, axes=(1, 3), norm="ortho").real.astype(u.dtype)
    y = jnp.einsum('bsgc,gcd->bsgd', mixed, w_f) + b_f
    return y.reshape(B, S, FOURIER_WIDTH)


def windowed_gqa(q, k, v, rel_bias, sink):
    B, S = q.shape[:2]
    nb = S // BLOCK
    span = BLOCK + 2 * WINDOW
    pad = ((0, 0), (WINDOW, WINDOW), (0, 0), (0, 0))
    kp = jnp.pad(k, pad)
    vp = jnp.pad(v, pad)
    rel = jnp.arange(span)[None, :] - WINDOW - jnp.arange(BLOCK)[:, None]
    bias = rel_bias[t5_bucket(rel)].astype(jnp.float32)
    bias = bias.transpose(2, 0, 1).reshape(N_KV_HEADS, Q_PER_KV, BLOCK, span)
    band = jnp.abs(rel) <= WINDOW
    sink_l = sink.astype(jnp.float32).reshape(N_KV_HEADS, Q_PER_KV, 1, 1)
    scale = HEAD_DIM ** -0.5

    def one_block(i):
        start = i * BLOCK
        qb = lax.dynamic_slice_in_dim(q, start, BLOCK, axis=1)
        kb = lax.dynamic_slice_in_dim(kp, start, span, axis=1)
        vb = lax.dynamic_slice_in_dim(vp, start, span, axis=1)
        kpos = start - WINDOW + jnp.arange(span)
        valid = band & ((kpos >= 0) & (kpos < S))[None, :]
        logits = jnp.einsum('bqkrd,bjkd->bkrqj', qb, kb).astype(jnp.float32) * scale + bias
        logits = jnp.where(valid, logits, -jnp.inf)
        m = jnp.maximum(jnp.max(logits, axis=-1, keepdims=True), sink_l)
        p = jnp.exp(logits - m)
        denom = jnp.sum(p, axis=-1, keepdims=True) + jnp.exp(sink_l - m)
        return jnp.einsum('bkrqj,bjkd->bqkrd', (p / denom).astype(vb.dtype), vb)

    outs = lax.map(one_block, jnp.arange(nb))
    return outs.transpose(1, 0, 2, 3, 4, 5).reshape(B, S, ATTN_WIDTH)


def expert_choice_moe(h, w_router, w_gate, w_up, w_down):
    B, S, D = h.shape
    cap = CAPACITY_FACTOR * S // N_EXPERTS
    aff = jax.nn.softmax(jnp.einsum('bsd,de->bse', h, w_router).astype(jnp.float32), axis=-1)
    g, idx = lax.top_k(aff.transpose(0, 2, 1), cap)
    xin = jax.vmap(lambda hb, ib: hb[ib])(h, idx)
    a = jnp.einsum('becd,edf->becf', xin, w_gate)
    u = jnp.einsum('becd,edf->becf', xin, w_up)
    y = jnp.einsum('becf,efd->becd', jax.nn.silu(a) * u, w_down)
    y = y * g[..., None].astype(y.dtype)
    return jax.vmap(lambda yb, ib: jnp.zeros((S, D), yb.dtype)
                    .at[ib.reshape(-1)].add(yb.reshape(-1, D)))(y, idx)


def setup_inputs(seed: int = 0) -> dict:
    key = jax.random.key(seed)
    ks = jax.random.split(key, 18)
    f32 = jnp.float32
    nrm = lambda k, shape, s: jax.random.normal(k, shape, f32) * s
    L, D = DEPTH, D_MODEL
    return {
        "x": nrm(ks[0], (BATCH, SEQ, D), 1.0),
        "c": nrm(ks[1], (BATCH, D), 1.0),
        "rel_bias": nrm(ks[2], (N_BUCKETS, N_Q_HEADS), 0.5),
        "w_ada": nrm(ks[3], (L, D, N_ADA * D), 0.5 * D ** -0.5),
        "b_ada": nrm(ks[4], (L, N_ADA * D), 0.02),
        "norm_mix_g": 1.0 + nrm(ks[5], (L, D), 0.02),
        "norm_ffn_g": 1.0 + nrm(ks[6], (L, D), 0.02),
        "w_in": nrm(ks[7], (L, D, IN_PROJ_WIDTH), D ** -0.5),
        "w_fourier": nrm(ks[8], (L, N_FOURIER_GROUPS, HEAD_DIM, HEAD_DIM), HEAD_DIM ** -0.5),
        "b_fourier": nrm(ks[9], (L, N_FOURIER_GROUPS, HEAD_DIM), 0.02),
        "q_norm_g": 1.0 + nrm(ks[10], (L, HEAD_DIM), 0.02),
        "k_norm_g": 1.0 + nrm(ks[11], (L, HEAD_DIM), 0.02),
        "sink": nrm(ks[12], (L, N_Q_HEADS), 1.0),
        "w_out": nrm(ks[13], (L, MIX_WIDTH, D), MIX_WIDTH ** -0.5),
        "w_router": nrm(ks[14], (L, D, N_EXPERTS), D ** -0.5),
        "w_gate": nrm(ks[15], (L, N_EXPERTS, D, D_EXPERT), D ** -0.5),
        "w_up": nrm(ks[16], (L, N_EXPERTS, D, D_EXPERT), D ** -0.5),
        "w_down": nrm(ks[17], (L, N_EXPERTS, D_EXPERT, D), D_EXPERT ** -0.5),
    }


def reference(x, c, rel_bias, w_ada, b_ada, norm_mix_g, norm_ffn_g, w_in, w_fourier,
              b_fourier, q_norm_g, k_norm_g, sink, w_out, w_router, w_gate, w_up, w_down):
    B, S, _ = x.shape
    split_cols = [FOURIER_WIDTH, FOURIER_WIDTH + ATTN_WIDTH, FOURIER_WIDTH + ATTN_WIDTH + KV_WIDTH]
    c_act = jax.nn.silu(c)
    for l in range(DEPTH):
        mod = jnp.einsum('bd,de->be', c_act, w_ada[l]) + b_ada[l]
        sh1, sc1, g1, sh2, sc2, g2 = [m[:, None, :] for m in jnp.split(mod, N_ADA, axis=-1)]

        h = rmsnorm(x, norm_mix_g[l]) * (1.0 + sc1) + sh1
        proj = jnp.einsum('bsd,de->bse', h, w_in[l])
        u_f, q, k, v = jnp.split(proj, split_cols, axis=-1)
        q = rmsnorm(q.reshape(B, S, N_KV_HEADS, Q_PER_KV, HEAD_DIM), q_norm_g[l])
        k = rmsnorm(k.reshape(B, S, N_KV_HEADS, HEAD_DIM), k_norm_g[l])
        v = v.reshape(B, S, N_KV_HEADS, HEAD_DIM)
        y_f = fourier_mix(u_f, w_fourier[l], b_fourier[l])
        y_a = windowed_gqa(q, k, v, rel_bias, sink[l])
        mixed = jnp.einsum('bse,ed->bsd', jnp.concatenate([y_f, y_a], axis=-1), w_out[l])
        x = x + g1 * mixed

        h2 = rmsnorm(x, norm_ffn_g[l]) * (1.0 + sc2) + sh2
        x = x + g2 * expert_choice_moe(h2, w_router[l], w_gate[l], w_up[l], w_down[l])
    return x
```

```cpp
#include <hip/hip_runtime.h>
#include <cstdio>
#include <cstdint>

#define LAS __attribute__((address_space(3)))
#define GAS __attribute__((address_space(1)))
typedef unsigned short bf16;
typedef unsigned v4u __attribute__((ext_vector_type(4)));
typedef unsigned v2u __attribute__((ext_vector_type(2)));
typedef float f32x4 __attribute__((ext_vector_type(4)));
typedef short bf16x8 __attribute__((ext_vector_type(8)));

constexpr int NB = 32, SEQ = 2048, DM = 1024, MTOK = NB * SEQ;
constexpr int NPROJ = 1280, FW = 512, KOUT = 1024;
constexpr int NEXP = 16, CAP = 256, DEXP = 1024, NPAIR = NB * NEXP, NSLOT = NPAIR * CAP;
constexpr int NADA = 6 * DM;
constexpr float EPS = 1e-6f;
constexpr float LOG2E = 1.4426950408889634f;

constexpr size_t MiB = 1u << 20;
constexpr size_t WS_CTL = 0, CTL_BYTES = 1 * MiB;
constexpr size_t WS_MOD = 1 * MiB;
constexpr size_t WS_MAT = 1 * MiB + 896 * 1024;
constexpr size_t WS_MBT = 1 * MiB + 960 * 1024;
constexpr size_t WS_WIN = 2 * MiB;
constexpr size_t WS_WOUT = 5 * MiB;
constexpr size_t WS_T = 8 * MiB;
constexpr size_t WS_WGU = 16 * MiB;
constexpr size_t WS_WD = 80 * MiB;
constexpr size_t WS_AFF = 112 * MiB;
constexpr size_t WS_IDX = 116 * MiB;
constexpr size_t WS_GATE = 116 * MiB + 512 * 1024;
constexpr size_t WS_INV = 117 * MiB;
constexpr size_t WS_K = 122 * MiB;
constexpr size_t WS_V = 138 * MiB;
constexpr size_t WS_H = 160 * MiB;
constexpr size_t WS_ET = 288 * MiB;
constexpr size_t WS_OT = 320 * MiB;
constexpr size_t WS_U1024 = 1 * MiB + 832 * 1024;
constexpr size_t WS_Q = 352 * MiB;
constexpr size_t WS_YB = 160 * MiB;
constexpr size_t WS_Y = 416 * MiB;
constexpr size_t WS_PA = 544 * MiB;
constexpr size_t WS_H2 = 416 * MiB;
constexpr size_t WS_ACT = 608 * MiB;
constexpr size_t WS_DELTA = 864 * MiB;
constexpr size_t WS_END = 992 * MiB;

typedef __bf16 bf16x2_t __attribute__((ext_vector_type(2)));
__device__ __forceinline__ unsigned f2bf(float f) { return (unsigned)__builtin_bit_cast(unsigned short, (__bf16)f); }
__device__ __forceinline__ unsigned pk2(float lo, float hi) { bf16x2_t v; v.x = (__bf16)lo; v.y = (__bf16)hi; return __builtin_bit_cast(unsigned, v); }
__device__ __forceinline__ unsigned pk4_fp8(float a, float b, float c, float d) { int w = 0; w = __builtin_amdgcn_cvt_pk_fp8_f32(a, b, w, false); w = __builtin_amdgcn_cvt_pk_fp8_f32(c, d, w, true); return (unsigned)w; }
constexpr float W8S = 32.f, W8I = 1.f / 32.f;
__device__ __forceinline__ float bf2f(unsigned b) { return __builtin_bit_cast(float, b << 16); }
__device__ __forceinline__ float wave_sum(float v) {
#pragma unroll
    for (int o = 1; o < 64; o <<= 1) v += __shfl_xor(v, o);
    return v;
}
__device__ __forceinline__ float wave_max(float v) {
#pragma unroll
    for (int o = 1; o < 64; o <<= 1) v = fmaxf(v, __shfl_xor(v, o));
    return v;
}
__device__ __forceinline__ int lane_fresh() { int l; asm volatile("v_mbcnt_lo_u32_b32 %0, -1, 0\n\tv_mbcnt_hi_u32_b32 %0, -1, %0" : "=v"(l)); return l; }
__device__ __forceinline__ int t5_bucket(int rel) {
    const int ret = rel > 0 ? 16 : 0; const int n = rel < 0 ? -rel : rel;
    if (n < 8) return ret + n;
    int lg = 31 - __builtin_clz((unsigned)(n * n)) - 6;
    lg = lg > 7 ? 7 : lg;
    return ret + 8 + lg;
}

struct Args {
    const float* in[18]; float* out; unsigned char* ws; int ph_lo, ph_hi, li, pad;
};
typedef const __attribute__((address_space(4))) Args* KArgs;
__device__ __forceinline__ KArgs kargs() { KArgs p = (KArgs)__builtin_amdgcn_kernarg_segment_ptr(); asm volatile("" : "+s"(p)); return p; }
enum { I_X = 0, I_C, I_RELB, I_WADA, I_BADA, I_NMG, I_NFG, I_WIN, I_WF, I_BF, I_QG, I_KG, I_SINK, I_WOUT, I_WR, I_WG, I_WU, I_WD };

constexpr int NWAVES = 8, NTHR = 512;
constexpr int LDS_BYTES = 155648;

__device__ __forceinline__ void p0_fill_cs(const float* c, LAS float* cs, int tid) {
    for (int it = 0; it < 16; ++it) { const int k = it * 64 + (tid >> 3), b4 = tid & 7; f32x4 v;
#pragma unroll
        for (int j = 0; j < 4; ++j) { const float x = c[(4 * b4 + j) * DM + k]; v[j] = x / (1.f + expf(-x)); }
        *(LAS f32x4*)(cs + k * 32 + 4 * b4) = v; }
}
__device__ __forceinline__ void p0_mod(KArgs a, LAS unsigned char* lds, int tid, int G) {
    LAS float* cs = (LAS float*)lds;
    const float* c = a->in[I_C];
    p0_fill_cs(c, cs, tid);
    __syncthreads();
    float* MOD = (float*)(a->ws + WS_MOD);
    const float* w_ada = a->in[I_WADA]; const float* b_ada = a->in[I_BADA];
    const int wave = tid >> 6, lane = tid & 63, kk = lane >> 5, j = lane & 31;
    for (int it = blockIdx.x; it < 256; it += G) {
        const int col0 = it * 24;
        float acc[32];
#pragma unroll
        for (int b = 0; b < 32; ++b) acc[b] = 0.f;
        if (j < 24) {
#pragma unroll 1
            for (int hf = 0; hf < 4; ++hf) {
                float w[16];
#pragma unroll
                for (int i = 0; i < 16; ++i) w[i] = w_ada[(size_t)(wave * 128 + 2 * (hf * 16 + i) + kk) * NADA + col0 + j];
#pragma unroll
                for (int i = 0; i < 16; ++i) { const int k = wave * 128 + 2 * (hf * 16 + i) + kk;
#pragma unroll
                    for (int b4 = 0; b4 < 8; ++b4) { const f32x4 cv = *(const LAS f32x4*)(cs + k * 32 + 4 * b4); acc[4 * b4] += cv.x * w[i]; acc[4 * b4 + 1] += cv.y * w[i]; acc[4 * b4 + 2] += cv.z * w[i]; acc[4 * b4 + 3] += cv.w * w[i]; }
                    asm volatile("" ::: "memory"); }
            }
        }
        __syncthreads();
        LAS float* part = (LAS float*)lds;
        if (j < 24) {
#pragma unroll
            for (int b = 0; b < 32; ++b) part[((wave * 2 + kk) * 32 + b) * 24 + j] = acc[b]; }
        __syncthreads();
        for (int o = tid; o < 768; o += NTHR) { const int bb = o / 24, jj = o % 24; float s = b_ada[col0 + jj];
            for (int p = 0; p < 16; ++p) s += part[(p * 32 + bb) * 24 + jj];
            MOD[bb * NADA + col0 + jj] = s; }
        __syncthreads();
        if (it + G < 256) { p0_fill_cs(c, cs, tid); __syncthreads(); }
    }
}
__device__ __forceinline__ void p0_item_load(const float* src, int N, int lane, f32x4 (&v)[16]) {
#pragma unroll
    for (int i = 0; i < 16; ++i) v[i] = __builtin_nontemporal_load((const f32x4*)(src + (size_t)(4 * i + (lane >> 4)) * N + 4 * (lane & 15)));
}
__device__ __forceinline__ void p0_item_to_lds(const f32x4 (&v)[16], LAS float* scr, int lane) {
#pragma unroll
    for (int i = 0; i < 16; ++i) { const int kk = 4 * i + (lane >> 4); *(LAS f32x4*)(scr + kk * 64 + 4 * ((lane & 15) ^ (kk >> 3))) = v[i]; }
    asm volatile("s_waitcnt lgkmcnt(0)" ::: "memory");
}
__device__ __forceinline__ void p0_item_bf16(const f32x4 (&v)[16], bf16* WT, int ldk, int drow0, int hi_off, LAS float* scr, int k0, int lane) {
    p0_item_to_lds(v, scr, lane);
    const int c = lane & 7;
#pragma unroll
    for (int j = 0; j < 8; ++j) { const int n = (lane >> 3) + 8 * j; float e[8];
#pragma unroll
        for (int t = 0; t < 8; ++t) e[t] = scr[(8 * c + t) * 64 + 4 * ((n >> 2) ^ c) + (n & 3)];
        v4u o; o.x = pk2(e[0], e[1]); o.y = pk2(e[2], e[3]); o.z = pk2(e[4], e[5]); o.w = pk2(e[6], e[7]);
        *(v4u*)(WT + (size_t)(drow0 + (n & 31) + hi_off * (n >> 5)) * ldk + k0 + 8 * c) = o; }
    asm volatile("s_waitcnt lgkmcnt(0)" ::: "memory");
}
__device__ __forceinline__ void p0_item_fp8(const f32x4 (&v)[16], unsigned char* WT, int drow0, LAS float* scr, int k0, int lane) {
    p0_item_to_lds(v, scr, lane);
    const int n = lane;
#pragma unroll
    for (int c = 0; c < 8; c += 2) { float e[16];
#pragma unroll
        for (int t = 0; t < 16; ++t) { const int k = 8 * c + t; e[t] = scr[k * 64 + 4 * ((n >> 2) ^ (k >> 3)) + (n & 3)] * W8S; }
        v4u o; o.x = pk4_fp8(e[0], e[1], e[2], e[3]); o.y = pk4_fp8(e[4], e[5], e[6], e[7]); o.z = pk4_fp8(e[8], e[9], e[10], e[11]); o.w = pk4_fp8(e[12], e[13], e[14], e[15]);
        *(v4u*)(WT + (size_t)(drow0 + n) * 1024 + k0 + 8 * c) = o; }
    asm volatile("s_waitcnt lgkmcnt(0)" ::: "memory");
}
__device__ __forceinline__ void p0_maps(KArgs a, LAS unsigned char* lds, int tid, int G) {
    LAS float* wf = (LAS float*)lds;
    LAS float* ct = wf + 4096;
    LAS float* st = ct + 64;
    bf16* MAT = (bf16*)(a->ws + WS_MAT); bf16* MBT = (bf16*)(a->ws + WS_MBT);
    const float* w_f = a->in[I_WF];
    const float scale = 0.0027621358640099515f;
    for (int g = blockIdx.x; g < 8; g += G) {
        for (int i = tid; i < 4096; i += NTHR) wf[i] = w_f[g * 4096 + i];
        if (tid < 64) { ct[tid] = cospif((float)tid / 32.f); st[tid] = sinpif((float)tid / 32.f); }
        __syncthreads();
        for (int o = tid; o < 4096; o += NTHR) { const int d = o >> 6, c = o & 63; float sc = 0.f, ss = 0.f;
            for (int m = 0; m < 64; ++m) { const float w = wf[m * 64 + d]; const int ph = (m * c) & 63; sc += ct[ph] * w; ss += st[ph] * w; }
            MAT[g * 4096 + o] = (bf16)f2bf(sc * scale); MBT[g * 4096 + o] = (bf16)f2bf(-ss * scale); }
        __syncthreads();
    }
}
__device__ __forceinline__ void p0_rest(KArgs a, LAS unsigned char* lds, int tid, int wave, int lane, int vcu, int G) {
    LAS float* scr = (LAS float*)(lds + wave * 16384);
    const int gw = vcu * NWAVES + wave, NGW = G * NWAVES;
    bf16* WIN_T = (bf16*)(a->ws + WS_WIN); bf16* WOUT_T = (bf16*)(a->ws + WS_WOUT); unsigned char* WGU = a->ws + WS_WGU; unsigned char* WD = a->ws + WS_WD;
    constexpr int I_A = 16 * 20, I_B = 16 * 16, I_E = 16 * 16;
    constexpr int NITEMS = I_A + I_B + 16 * 3 * I_E;
    auto src_of = [&](int it, const float*& src, int& N) { int r = it;
        if (r < I_A) { const int kb = r / 20, nb = r % 20; N = NPROJ; src = a->in[I_WIN] + (size_t)(kb * 64) * NPROJ + nb * 64; return; }
        r -= I_A;
        if (r < I_B) { const int kb = r / 16, nb = r % 16; N = DM; src = a->in[I_WOUT] + (size_t)(kb * 64) * DM + nb * 64; return; }
        r -= I_B;
        const int e = r / (3 * I_E), r2 = r % (3 * I_E), which = r2 / I_E, r3 = r2 % I_E, kb = r3 / 16, nb = r3 % 16;
        if (which == 0) { N = DEXP; src = a->in[I_WG] + (size_t)e * DM * DEXP + (size_t)(kb * 64) * DEXP + nb * 64; }
        else if (which == 1) { N = DEXP; src = a->in[I_WU] + (size_t)e * DM * DEXP + (size_t)(kb * 64) * DEXP + nb * 64; }
        else { N = DM; src = a->in[I_WD] + (size_t)e * DEXP * DM + (size_t)(kb * 64) * DM + nb * 64; } };
    f32x4 cur[16], nxt[16];
    { const float* src; int N; if (gw < NITEMS) { src_of(gw, src, N); p0_item_load(src, N, lane, cur); } }
    for (int it = gw; it < NITEMS; it += NGW) {
        if (it + NGW < NITEMS) { const float* src; int N; src_of(it + NGW, src, N); p0_item_load(src, N, lane, nxt); }
        int r = it;
        if (r < I_A) { const int kb = r / 20, nb = r % 20, n0 = nb * 64;
            const int t = n0 >> 8, hh = (n0 & 255) >> 6, drow = 256 * t + 32 * hh;
            p0_item_bf16(cur, WIN_T, DM, drow, 128, scr, kb * 64, lane); }
        else if (r < I_A + I_B) { r -= I_A; const int kb = r / 16, nb = r % 16; p0_item_bf16(cur, WOUT_T, KOUT, nb * 64, 32, scr, kb * 64, lane); }
        else { r -= I_A + I_B;
            const int e = r / (3 * I_E), r2 = r % (3 * I_E), which = r2 / I_E, r3 = r2 % I_E, kb = r3 / 16, nb = r3 % 16, n0 = nb * 64;
            if (which == 2) p0_item_fp8(cur, WD + (size_t)e * 1024 * 1024, n0, scr, kb * 64, lane);
            else p0_item_fp8(cur, WGU + (size_t)e * 2048 * 1024, 256 * (n0 >> 7) + 128 * which + (n0 & 127), scr, kb * 64, lane); }
#pragma unroll
        for (int i = 0; i < 16; ++i) cur[i] = nxt[i];
    }
    bf16* T = (bf16*)(a->ws + WS_T);
    for (int r = gw; r < 2048; r += NGW) {
#pragma unroll
        for (int i2 = 0; i2 < 2; ++i2) { const int s0 = i2 * 512 + lane * 8; float v[8];
#pragma unroll
            for (int j = 0; j < 8; ++j) { const int sp = s0 + j;
                v[j] = (r < 1024) ? cospif((float)((r * sp) & 2047) / 1024.f) : sinpif((float)(((r - 1024) * sp) & 2047) / 1024.f); }
            v4u o; o.x = pk2(v[0], v[1]); o.y = pk2(v[2], v[3]); o.z = pk2(v[4], v[5]); o.w = pk2(v[6], v[7]);
            *(v4u*)(T + (size_t)r * 1024 + s0) = o; }
    }
}

__device__ __forceinline__ void ld_row_f32(const float* p, int lane, f32x4 (&v)[4]) {
    v[0] = __builtin_nontemporal_load((const f32x4*)(p + 8 * lane)); v[1] = __builtin_nontemporal_load((const f32x4*)(p + 8 * lane + 4)); v[2] = __builtin_nontemporal_load((const f32x4*)(p + 512 + 8 * lane)); v[3] = __builtin_nontemporal_load((const f32x4*)(p + 512 + 8 * lane + 4)); }
__device__ __forceinline__ void ld_row_f32c(const float* p, int lane, f32x4 (&v)[4]) {
    v[0] = *(const f32x4*)(p + 8 * lane); v[1] = *(const f32x4*)(p + 8 * lane + 4); v[2] = *(const f32x4*)(p + 512 + 8 * lane); v[3] = *(const f32x4*)(p + 512 + 8 * lane + 4); }
__device__ __forceinline__ void ld_row_bf(const bf16* p, int lane, v4u (&d)[2]) { d[0] = __builtin_nontemporal_load((const v4u*)(p + 8 * lane)); d[1] = __builtin_nontemporal_load((const v4u*)(p + 512 + 8 * lane)); }
__device__ __forceinline__ void add_bf(f32x4 (&v)[4], const v4u (&d)[2]) {
#pragma unroll
    for (int h = 0; h < 2; ++h) { v[2 * h].x += bf2f(d[h].x & 0xffffu); v[2 * h].y += bf2f(d[h].x >> 16); v[2 * h].z += bf2f(d[h].y & 0xffffu); v[2 * h].w += bf2f(d[h].y >> 16);
        v[2 * h + 1].x += bf2f(d[h].z & 0xffffu); v[2 * h + 1].y += bf2f(d[h].z >> 16); v[2 * h + 1].z += bf2f(d[h].w & 0xffffu); v[2 * h + 1].w += bf2f(d[h].w >> 16); } }
__device__ __forceinline__ void st_row_bf(bf16* p, int lane, const f32x4 (&v)[4]) {
#pragma unroll
    for (int h = 0; h < 2; ++h) { v4u w; w.x = pk2(v[2 * h].x, v[2 * h].y); w.y = pk2(v[2 * h].z, v[2 * h].w); w.z = pk2(v[2 * h + 1].x, v[2 * h + 1].y); w.w = pk2(v[2 * h + 1].z, v[2 * h + 1].w); __builtin_nontemporal_store(w, (v4u*)(p + 512 * h + 8 * lane)); } }
__device__ __forceinline__ void st_row_bf_plain(bf16* p, int lane, const f32x4 (&v)[4]) {
#pragma unroll
    for (int h = 0; h < 2; ++h) { v4u w; w.x = pk2(v[2 * h].x, v[2 * h].y); w.y = pk2(v[2 * h].z, v[2 * h].w); w.z = pk2(v[2 * h + 1].x, v[2 * h + 1].y); w.w = pk2(v[2 * h + 1].z, v[2 * h + 1].w); *(v4u*)(p + 512 * h + 8 * lane) = w; } }
__device__ __forceinline__ void ld_row_fp8(const unsigned char* p, int lane, v2u (&d)[2]) { d[0] = __builtin_nontemporal_load((const v2u*)(p + 8 * lane)); d[1] = __builtin_nontemporal_load((const v2u*)(p + 512 + 8 * lane)); }
__device__ __forceinline__ void add_fp8(f32x4 (&v)[4], const v2u (&d)[2]) {
    typedef float f2 __attribute__((ext_vector_type(2)));
#pragma unroll
    for (int h = 0; h < 2; ++h) { const f2 a = __builtin_amdgcn_cvt_pk_f32_fp8((int)d[h].x, false), b = __builtin_amdgcn_cvt_pk_f32_fp8((int)d[h].x, true), c = __builtin_amdgcn_cvt_pk_f32_fp8((int)d[h].y, false), e = __builtin_amdgcn_cvt_pk_f32_fp8((int)d[h].y, true);
        v[2 * h].x += a.x; v[2 * h].y += a.y; v[2 * h].z += b.x; v[2 * h].w += b.y; v[2 * h + 1].x += c.x; v[2 * h + 1].y += c.y; v[2 * h + 1].z += e.x; v[2 * h + 1].w += e.y; } }
__device__ __forceinline__ void st_row_fp8(unsigned char* p, int lane, const f32x4 (&v)[4]) {
#pragma unroll
    for (int h = 0; h < 2; ++h) { v2u w; w.x = pk4_fp8(v[2 * h].x, v[2 * h].y, v[2 * h].z, v[2 * h].w); w.y = pk4_fp8(v[2 * h + 1].x, v[2 * h + 1].y, v[2 * h + 1].z, v[2 * h + 1].w); *(v2u*)(p + 512 * h + 8 * lane) = w; } }
__device__ __forceinline__ float ssq4(const f32x4 (&v)[4]) { float s = 0.f;
#pragma unroll
    for (int j = 0; j < 4; ++j) s += (v[j].x * v[j].x + v[j].y * v[j].y) + (v[j].z * v[j].z + v[j].w * v[j].w);
    return s; }

__device__ __forceinline__ size_t h_row(int tok) { const int b = tok >> 11, s_ = tok & 2047; int t, r;
    if (s_ < 1024) { t = s_ >> 7; r = s_ & 127; } else if (s_ == 1024) { t = 0; r = 128; } else { const int sp = SEQ - s_; t = sp >> 7; r = 128 + (sp & 127); }
    return (size_t)(b * 8 + t) * 256 + r; }
__device__ __forceinline__ void p1_pair(const f32x4 (&va)[4], const f32x4 (&vb)[4], const f32x4 (&gs)[4], const f32x4 (&sh)[4], bf16* ha, bf16* hb, int lane) {
    float s0 = ssq4(va), s1 = ssq4(vb);
#pragma unroll
    for (int o = 1; o < 64; o <<= 1) { s0 += __shfl_xor(s0, o); s1 += __shfl_xor(s1, o); }
    const float r0 = 1.f / sqrtf(s0 * (1.f / DM) + EPS), r1 = 1.f / sqrtf(s1 * (1.f / DM) + EPS);
    f32x4 o[4];
#pragma unroll
    for (int j = 0; j < 4; ++j) o[j] = va[j] * r0 * gs[j] + sh[j];
    st_row_bf_plain(ha, lane, o);
#pragma unroll
    for (int j = 0; j < 4; ++j) o[j] = vb[j] * r1 * gs[j] + sh[j];
    st_row_bf_plain(hb, lane, o);
}
__device__ __forceinline__ void p1_h(KArgs a, int wave, int lane, int vcu, int G) {
    const int gw = vcu * NWAVES + wave, NGW = G * NWAVES;
    const float* MOD = (const float*)(a->ws + WS_MOD); const float* g = a->in[I_NMG]; const float* x = a->in[I_X]; bf16* H = (bf16*)(a->ws + WS_H);
    f32x4 gg[4]; ld_row_f32c(g, lane, gg);
    const int nst = MTOK / 4 / NGW;
    f32x4 a0[4], a1[4], b0[4], b1[4];
    { const float* xr = x + (size_t)(4 * gw) * DM; ld_row_f32(xr, lane, a0); ld_row_f32(xr + DM, lane, a1); }
    for (int it = 0; it < nst; ++it) {
        const int row0 = 4 * (it * NGW + gw), b = row0 / SEQ;
        const float* xr = x + (size_t)row0 * DM;
        ld_row_f32(xr + 2 * DM, lane, b0); ld_row_f32(xr + 3 * DM, lane, b1);
        f32x4 gs[4], sh[4];
        { f32x4 sc[4]; ld_row_f32c(MOD + b * NADA + DM, lane, sc); ld_row_f32c(MOD + b * NADA, lane, sh);
#pragma unroll
          for (int j = 0; j < 4; ++j) gs[j] = gg[j] * (sc[j] + 1.f); }
        p1_pair(a0, a1, gs, sh, H + h_row(row0) * DM, H + h_row(row0 + 1) * DM, lane);
        if (it + 1 < nst) { const float* xn = x + (size_t)(4 * ((it + 1) * NGW + gw)) * DM; ld_row_f32(xn, lane, a0); ld_row_f32(xn + DM, lane, a1); }
        p1_pair(b0, b1, gs, sh, H + h_row(row0 + 2) * DM, H + h_row(row0 + 3) * DM, lane);
    }
}

__device__ __forceinline__ float bfly16(const float (&t)[16], int lane) {
    const bool b5 = lane & 32, b4 = lane & 16, b3 = lane & 8, b2 = lane & 4;
    float u8[8], u4[4], u2[2], u1;
#pragma unroll
    for (int i = 0; i < 8; ++i) { const float send = b5 ? t[i] : t[i + 8], keep = b5 ? t[i + 8] : t[i]; u8[i] = keep + __shfl_xor(send, 32); }
#pragma unroll
    for (int i = 0; i < 4; ++i) { const float send = b4 ? u8[i] : u8[i + 4], keep = b4 ? u8[i + 4] : u8[i]; u4[i] = keep + __shfl_xor(send, 16); }
#pragma unroll
    for (int i = 0; i < 2; ++i) { const float send = b3 ? u4[i] : u4[i + 2], keep = b3 ? u4[i + 2] : u4[i]; u2[i] = keep + __shfl_xor(send, 8); }
    { const float send = b2 ? u2[0] : u2[1], keep = b2 ? u2[1] : u2[0]; u1 = keep + __shfl_xor(send, 4); }
    u1 += __shfl_xor(u1, 2); u1 += __shfl_xor(u1, 1);
    return u1;
}
__device__ __forceinline__ void dot16(const f32x4 (&v)[4], const LAS float* wr, int lane, float (&t)[16]) {
#pragma unroll
    for (int e = 0; e < 16; ++e) { float t0 = 0.f;
#pragma unroll
        for (int j = 0; j < 4; ++j) { const f32x4 w4 = *(const LAS f32x4*)(wr + e * 1024 + 256 * j + 4 * lane); t0 += (v[j].x * w4.x + v[j].y * w4.y) + (v[j].z * w4.z + v[j].w * w4.w); }
        t[e] = t0; asm volatile("" ::: "memory"); }
}
__device__ __forceinline__ void dot16x2(const f32x4 (&v0)[4], const f32x4 (&v1)[4], const LAS float* wr, int lane, float (&t0)[16], float (&t1)[16]) {
#pragma unroll
    for (int e = 0; e < 16; ++e) { f32x4 a0 = {0.f, 0.f, 0.f, 0.f}, a1 = a0;
#pragma unroll
        for (int j = 0; j < 4; ++j) { const f32x4 w4 = *(const LAS f32x4*)(wr + e * 1024 + 256 * j + 4 * lane); a0 += v0[j] * w4; a1 += v1[j] * w4; }
        t0[e] = (a0.x + a0.y) + (a0.z + a0.w); t1[e] = (a1.x + a1.y) + (a1.z + a1.w); asm volatile("" ::: "memory"); }
}
__device__ __forceinline__ void p5_router(KArgs a, LAS unsigned char* lds, int tid, int wave, int lane, int vcu, int G) {
    LAS float* wr = (LAS float*)lds;
    const float* w_router = a->in[I_WR];
    for (int i = tid; i < DM * NEXP; i += NTHR) { const int k = i >> 4, e = i & 15;
        wr[e * 1024 + 256 * (2 * (k >> 9) + ((k >> 2) & 1)) + 4 * ((k >> 3) & 63) + (k & 3)] = w_router[i]; }
    __syncthreads();
    const int gw = vcu * NWAVES + wave, NGW = G * NWAVES;
    const float* MOD = (const float*)(a->ws + WS_MOD); const float* g = a->in[I_NFG]; const float* x = a->in[I_X]; const bf16* DELTA = (const bf16*)(a->ws + WS_DELTA);
    unsigned char* H2 = a->ws + WS_H2; float* AFF = (float*)(a->ws + WS_AFF);
    for (int blk = gw; blk < MTOK / 32; blk += NGW) {
        const int row0 = blk * 32, b = row0 / SEQ;
        f32x4 gs[4], sh[4]; float ce;
        { f32x4 gg[4], sc[4]; ld_row_f32c(g, lane, gg); ld_row_f32c(MOD + b * NADA + 4 * DM, lane, sc); ld_row_f32c(MOD + b * NADA + 3 * DM, lane, sh);
#pragma unroll
          for (int j = 0; j < 4; ++j) gs[j] = gg[j] * (sc[j] + 1.f);
          float t[16]; dot16(sh, wr, lane, t); ce = bfly16(t, lane); }
        const float* xr = x + (size_t)row0 * DM; const bf16* dr = DELTA + (size_t)row0 * DM;
        f32x4 vn0[4], vn1[4]; v4u dn0[2], dn1[2];
        ld_row_f32(xr, lane, vn0); ld_row_bf(dr, lane, dn0); ld_row_f32(xr + DM, lane, vn1); ld_row_bf(dr + DM, lane, dn1);
        for (int r = 0; r < 32; r += 2) {
            f32x4 v0[4], v1[4];
#pragma unroll
            for (int j = 0; j < 4; ++j) { v0[j] = vn0[j]; v1[j] = vn1[j]; }
            add_bf(v0, dn0); add_bf(v1, dn1);
            if (r + 2 < 32) { ld_row_f32(xr + (size_t)(r + 2) * DM, lane, vn0); ld_row_bf(dr + (size_t)(r + 2) * DM, lane, dn0); ld_row_f32(xr + (size_t)(r + 3) * DM, lane, vn1); ld_row_bf(dr + (size_t)(r + 3) * DM, lane, dn1); }
            float s0 = ssq4(v0), s1 = ssq4(v1);
#pragma unroll
            for (int j = 0; j < 4; ++j) { v0[j] = v0[j] * gs[j]; v1[j] = v1[j] * gs[j]; }
            float t0[16], t1[16]; dot16x2(v0, v1, wr, lane, t0, t1);
            float lg0 = bfly16(t0, lane), lg1 = bfly16(t1, lane);
#pragma unroll
            for (int o = 1; o < 64; o <<= 1) { s0 += __shfl_xor(s0, o); s1 += __shfl_xor(s1, o); }
            const float rs0 = 1.f / sqrtf(s0 * (1.f / DM) + EPS), rs1 = 1.f / sqrtf(s1 * (1.f / DM) + EPS);
#pragma unroll
            for (int j = 0; j < 4; ++j) { v0[j] = v0[j] * rs0 + sh[j]; v1[j] = v1[j] * rs1 + sh[j]; }
            st_row_fp8(H2 + (size_t)(row0 + r) * DM, lane, v0); st_row_fp8(H2 + (size_t)(row0 + r + 1) * DM, lane, v1);
            lg0 = lg0 * rs0 + ce; lg1 = lg1 * rs1 + ce;
            float mx0 = lg0, mx1 = lg1;
#pragma unroll
            for (int o = 4; o < 64; o <<= 1) { mx0 = fmaxf(mx0, __shfl_xor(mx0, o)); mx1 = fmaxf(mx1, __shfl_xor(mx1, o)); }
            const float p0 = expf(lg0 - mx0), p1 = expf(lg1 - mx1); float sum0 = p0, sum1 = p1;
#pragma unroll
            for (int o = 4; o < 64; o <<= 1) { sum0 += __shfl_xor(sum0, o); sum1 += __shfl_xor(sum1, o); }
            if ((lane & 3) == 0) { float* ap = AFF + ((size_t)b * NEXP + ((lane >> 2) & 15)) * SEQ + (row0 + r - b * SEQ); ap[0] = p0 / sum0; ap[1] = p1 / sum1; }
        }
    }
    __syncthreads();
}

__device__ __forceinline__ void p6_topk(KArgs a, LAS unsigned char* lds, int tid, int G) {
    LAS unsigned* hist = (LAS unsigned*)lds;
    LAS unsigned* sel = hist + 256;
    LAS unsigned* wtot = hist + 264;
    const float* AFF = (const float*)(a->ws + WS_AFF); int* IDX = (int*)(a->ws + WS_IDX); float* GATE = (float*)(a->ws + WS_GATE); int* INV = (int*)(a->ws + WS_INV);
    const int lane = tid & 63, wave = tid >> 6;
    for (int it = blockIdx.x; it < NPAIR; it += G) {
        const int b = it >> 4, e = it & 15;
        const v4u kv = *(const v4u*)(AFF + (size_t)it * SEQ + 4 * tid);
        const unsigned key[4] = {kv.x, kv.y, kv.z, kv.w};
        unsigned prefix = 0u, mask = 0u, krem = CAP;
#pragma unroll 1
        for (int shift = 24; shift >= 0; shift -= 8) {
            if (tid < 256) hist[tid] = 0u;
            __syncthreads();
#pragma unroll
            for (int i = 0; i < 4; ++i) if ((key[i] & mask) == prefix) __hip_atomic_fetch_add(hist + ((key[i] >> shift) & 255u), 1u, __ATOMIC_RELAXED, __HIP_MEMORY_SCOPE_WORKGROUP);
            __syncthreads();
            if (wave == 0) {
                const unsigned h0 = hist[4 * lane], h1 = hist[4 * lane + 1], h2 = hist[4 * lane + 2], h3 = hist[4 * lane + 3];
                const unsigned tot = h0 + h1 + h2 + h3; unsigned inc = tot;
#pragma unroll
                for (int o = 1; o < 64; o <<= 1) { const unsigned t = __shfl_down(inc, o); if (lane + o < 64) inc += t; }
                const unsigned above3 = inc - tot, above2 = above3 + h3, above1 = above2 + h2, above0 = above1 + h1;
                if (above3 < krem && krem <= above3 + h3) { sel[0] = 4 * lane + 3; sel[1] = krem - above3; }
                if (above2 < krem && krem <= above2 + h2) { sel[0] = 4 * lane + 2; sel[1] = krem - above2; }
                if (above1 < krem && krem <= above1 + h1) { sel[0] = 4 * lane + 1; sel[1] = krem - above1; }
                if (above0 < krem && krem <= above0 + h0) { sel[0] = 4 * lane;     sel[1] = krem - above0; }
            }
            __syncthreads();
            prefix |= sel[0] << shift; mask |= 255u << shift; krem = sel[1];
        }
        unsigned cg = 0, ce = 0;
#pragma unroll
        for (int i = 0; i < 4; ++i) { cg += key[i] > prefix; ce += key[i] == prefix; }
        unsigned pk = cg | (ce << 16), inc = pk;
#pragma unroll
        for (int o = 1; o < 64; o <<= 1) { const unsigned t = __shfl_up(inc, o); if (lane >= o) inc += t; }
        if (lane == 63) wtot[wave] = inc;
        __syncthreads();
        unsigned base = 0;
        for (int w = 0; w < wave; ++w) base += wtot[w];
        unsigned excl = base + inc - pk; unsigned ng = excl & 0xffffu, ne = excl >> 16;
#pragma unroll
        for (int i = 0; i < 4; ++i) { const int s_ = 4 * tid + i; int slot = -1;
            if (key[i] > prefix) { slot = (int)(ng + (ne < krem ? ne : krem)); ++ng; }
            else if (key[i] == prefix) { if (ne < krem) slot = (int)(ng + ne); ++ne; }
            if (slot >= 0) { IDX[it * CAP + slot] = s_; GATE[it * CAP + slot] = __builtin_bit_cast(float, key[i]); }
            INV[((size_t)b * SEQ + s_) * NEXP + e] = slot; }
        __syncthreads();
    }
}

__device__ __forceinline__ void p9_rows2(const f32x4 (&xa)[4], const v4u (&da)[2], const f32x4 (&xb)[4], const v4u (&db)[2], int inv, int q0, const unsigned char* YBb, const f32x4 (&g2)[4], float* oa, float* ob, int lane) {
    f32x4 acc0[4], acc1[4];
#pragma unroll
    for (int j = 0; j < 4; ++j) { acc0[j] = (f32x4){0.f, 0.f, 0.f, 0.f}; acc1[j] = (f32x4){0.f, 0.f, 0.f, 0.f}; }
    const unsigned long long bal = __ballot(inv >= 0);
    unsigned m0 = (unsigned)(bal >> (16 * q0)) & 0xffffu, m1 = (unsigned)(bal >> (16 * q0 + 16)) & 0xffffu;
    while (m0 | m1) {
        int ea0 = -1, ea1 = -1, eb0 = -1, eb1 = -1;
        if (m0) { ea0 = __builtin_ctz(m0); m0 &= m0 - 1; } if (m0) { ea1 = __builtin_ctz(m0); m0 &= m0 - 1; }
        if (m1) { eb0 = __builtin_ctz(m1); m1 &= m1 - 1; } if (m1) { eb1 = __builtin_ctz(m1); m1 &= m1 - 1; }
        v2u ya0[2], ya1[2], yb0[2], yb1[2];
        if (ea0 >= 0) { const int c = __builtin_amdgcn_readlane(inv, q0 * 16 + ea0); ld_row_fp8(YBb + ((size_t)ea0 * CAP + c) * DM, lane, ya0); }
        if (ea1 >= 0) { const int c = __builtin_amdgcn_readlane(inv, q0 * 16 + ea1); ld_row_fp8(YBb + ((size_t)ea1 * CAP + c) * DM, lane, ya1); }
        if (eb0 >= 0) { const int c = __builtin_amdgcn_readlane(inv, q0 * 16 + 16 + eb0); ld_row_fp8(YBb + ((size_t)eb0 * CAP + c) * DM, lane, yb0); }
        if (eb1 >= 0) { const int c = __builtin_amdgcn_readlane(inv, q0 * 16 + 16 + eb1); ld_row_fp8(YBb + ((size_t)eb1 * CAP + c) * DM, lane, yb1); }
        if (ea0 >= 0) add_fp8(acc0, ya0); if (ea1 >= 0) add_fp8(acc0, ya1);
        if (eb0 >= 0) add_fp8(acc1, yb0); if (eb1 >= 0) add_fp8(acc1, yb1);
    }
    f32x4 o[4];
#pragma unroll
    for (int j = 0; j < 4; ++j) o[j] = xa[j];
    add_bf(o, da);
#pragma unroll
    for (int j = 0; j < 4; ++j) { o[j] = o[j] + g2[j] * acc0[j]; __builtin_nontemporal_store(o[j], (f32x4*)(oa + 512 * (j >> 1) + 8 * lane + 4 * (j & 1))); }
#pragma unroll
    for (int j = 0; j < 4; ++j) o[j] = xb[j];
    add_bf(o, db);
#pragma unroll
    for (int j = 0; j < 4; ++j) { o[j] = o[j] + g2[j] * acc1[j]; __builtin_nontemporal_store(o[j], (f32x4*)(ob + 512 * (j >> 1) + 8 * lane + 4 * (j & 1))); }
}
__device__ __forceinline__ void p9_combine(KArgs a, int wave, int lane, int vcu, int G) {
    const int gw = vcu * NWAVES + wave, NGW = G * NWAVES;
    const float* MOD = (const float*)(a->ws + WS_MOD); const unsigned char* YB = a->ws + WS_YB;   const int* INV = (const int*)(a->ws + WS_INV); float* out = a->out;
    const float* x = a->in[I_X]; const bf16* DELTA = (const bf16*)(a->ws + WS_DELTA);
    for (int blk = gw; blk < MTOK / 32; blk += NGW) {
        const int row0 = blk * 32, b = row0 / SEQ;
        f32x4 g2[4]; ld_row_f32c(MOD + b * NADA + 5 * DM, lane, g2);
#pragma unroll
        for (int j = 0; j < 4; ++j) g2[j] = g2[j] * W8I;
        const unsigned char* YBb = YB + (size_t)b * NEXP * CAP * DM;
        const float* xr = x + (size_t)row0 * DM; const bf16* dr = DELTA + (size_t)row0 * DM; float* orow = out + (size_t)row0 * DM;
        f32x4 xa0[4], xa1[4], xb0[4], xb1[4]; v4u da0[2], da1[2], db0[2], db1[2];
        ld_row_f32(xr, lane, xa0); ld_row_bf(dr, lane, da0); ld_row_f32(xr + DM, lane, xa1); ld_row_bf(dr + DM, lane, da1);
        int inv = INV[(size_t)row0 * NEXP + lane];
        for (int r = 0; r < 32; r += 4) {
            ld_row_f32(xr + (size_t)(r + 2) * DM, lane, xb0); ld_row_bf(dr + (size_t)(r + 2) * DM, lane, db0); ld_row_f32(xr + (size_t)(r + 3) * DM, lane, xb1); ld_row_bf(dr + (size_t)(r + 3) * DM, lane, db1);
            const int invn = (r + 4 < 32) ? INV[(size_t)(row0 + r + 4) * NEXP + lane] : 0;
            p9_rows2(xa0, da0, xa1, da1, inv, 0, YBb, g2, orow + (size_t)r * DM, orow + (size_t)(r + 1) * DM, lane);
            if (r + 4 < 32) { ld_row_f32(xr + (size_t)(r + 4) * DM, lane, xa0); ld_row_bf(dr + (size_t)(r + 4) * DM, lane, da0); ld_row_f32(xr + (size_t)(r + 5) * DM, lane, xa1); ld_row_bf(dr + (size_t)(r + 5) * DM, lane, da1); }
            p9_rows2(xb0, db0, xb1, db1, inv, 2, YBb, g2, orow + (size_t)(r + 2) * DM, orow + (size_t)(r + 3) * DM, lane);
            inv = invn;
        }
    }
}

#define XB_TMO      128
#define XB_XCNT(j)  (256  + 64 * (j))
#define XB_XSUB(j)  (1280 + 64 * (j))
#define XB_XGEN(j)  (2304 + 64 * (j))
#define XB_TOP      3328
#define XB_TOPGEN   3392
#define XCD_BAR_WORDS 3456
#define XB_SPIN_CAP (1u << 22)
__device__ __forceinline__ unsigned xb_ld(unsigned* p)              { return __hip_atomic_load(p, __ATOMIC_RELAXED, __HIP_MEMORY_SCOPE_AGENT); }
__device__ __forceinline__ unsigned xb_add(unsigned* p, unsigned v) { return __hip_atomic_fetch_add(p, v, __ATOMIC_RELAXED, __HIP_MEMORY_SCOPE_AGENT); }
__device__ __forceinline__ unsigned xb_xcc_id() { return (unsigned)__builtin_amdgcn_s_getreg((3 << 11) | 20) & 0xFu; }
#define XB_SPIN(cond, bar) do { unsigned _sp = 0; while (cond) { __builtin_amdgcn_s_sleep(1); \
    if ((++_sp & 255u) == 0u) { if (xb_ld(&(bar)[XB_TMO])) break; if (_sp > XB_SPIN_CAP) { atomicAdd(&(bar)[XB_TMO], 1u); break; } } } } while (0)
struct XcdBarrier { unsigned* bar; unsigned x; volatile LAS unsigned* st; };
__device__ __forceinline__ XcdBarrier xcd_barrier_post(unsigned* bar, volatile LAS unsigned* st, int wave) {
    XcdBarrier b; b.bar = bar; b.x = xb_xcc_id(); b.st = st;
    if (wave == 0 && lane_fresh() == 0) (void)xb_add(&bar[XB_XCNT(b.x)], 1u);
    return b;
}
__device__ __forceinline__ void xcd_barrier_complete(unsigned* bar, unsigned x, unsigned& nloc, unsigned& nx) {
    const unsigned G = gridDim.x * gridDim.y * gridDim.z;
    unsigned sum, cnt, mine, sp = 0u;
    for (;;) {
        sum = 0u; cnt = 0u; mine = 0u;
#pragma unroll
        for (unsigned j = 0; j < 16; ++j) { const unsigned c = xb_ld(&bar[XB_XCNT(j)]); sum += c; cnt += (c > 0u) ? 1u : 0u; mine = (j == x) ? c : mine; }
        if (sum == G) break;
        __builtin_amdgcn_s_sleep(1);
        if ((++sp & 255u) == 0u) { if (xb_ld(&bar[XB_TMO])) break; if (sp > XB_SPIN_CAP) { atomicAdd(&bar[XB_TMO], 1u); break; } }
    }
    nloc = mine > 0u ? mine : 1u; nx = cnt > 0u ? cnt : 1u;
}
__device__ __forceinline__ void xcd_barrier(const XcdBarrier& b, int wave) {
    asm volatile("s_waitcnt vmcnt(0)" ::: "memory");
    __syncthreads();
    if (wave == 0 && lane_fresh() == 0) {
        unsigned* bar = b.bar;
        __builtin_amdgcn_s_waitcnt(0);
        unsigned nloc = b.st[0], nx = b.st[1];
        if (nloc == 0u) { xcd_barrier_complete(bar, b.x, nloc, nx); b.st[0] = nloc; b.st[1] = nx; }
        const unsigned old = xb_add(&bar[XB_XSUB(b.x)], 1u);
        const unsigned gen = old / nloc;
        if (old + 1u == (gen + 1u) * nloc) {
            __builtin_amdgcn_fence(__ATOMIC_RELEASE, "agent");
            asm volatile("s_waitcnt vmcnt(0)" ::: "memory");
            const unsigned og = xb_add(&bar[XB_TOP], 1u);
            const unsigned tg = og / nx;
            if (og + 1u == (tg + 1u) * nx) xb_add(&bar[XB_TOPGEN], 1u);
            else XB_SPIN(xb_ld(&bar[XB_TOPGEN]) == tg, bar);
            __builtin_amdgcn_fence(__ATOMIC_ACQUIRE, "agent");
            xb_add(&bar[XB_XGEN(b.x)], 1u);
            asm volatile("s_waitcnt vmcnt(0)" ::: "memory");
        } else {
            XB_SPIN(xb_ld(&bar[XB_XGEN(b.x)]) == gen, bar);
            __builtin_amdgcn_fence(__ATOMIC_ACQUIRE, "agent");
            asm volatile("s_waitcnt vmcnt(0)" ::: "memory");
        }
    }
    __syncthreads();
}

#ifndef PG8_ALIGN_EPI
#define PG8_ALIGN_EPI 1
#endif
namespace pg8 {
constexpr int BM = 256, BK = 64, HALF = 128, HTB = HALF * BK * 2, STAGE_BYTES = 8 * HTB, NXCD = 8, WGM = 8;
constexpr int UTAB_OFF = 147456 + 1024, MAXU = 24;
__host__ __device__ __forceinline__ int lds_byte(int r, int c) { const int st = (r >> 4) * 2 + (c >> 5), rr = r & 15, cc = c & 31, ob = rr * 64 + cc * 2; return st * 1024 + (ob ^ (((ob >> 9) & 1) << 5)); }
__host__ __device__ __forceinline__ void stage_rc(int b, int& R, int& C) { const int st = b / 1024, sb = b % 1024, swz = sb ^ (((sb >> 9) & 1) << 5); R = (st >> 1) * 16 + swz / 64; C = (st & 1) * 32 + (swz % 64) / 2; }
__host__ __device__ __forceinline__ int perm32(int rho) { const int n = rho >> 4, i = rho & 15; return 8 * (i >> 2) + 4 * n + (i & 3); }
typedef int v8i __attribute__((ext_vector_type(8))); typedef int v4i __attribute__((ext_vector_type(4)));
__device__ __forceinline__ v8i cat8(bf16x8 lo, bf16x8 hi) { return __builtin_shufflevector(__builtin_bit_cast(v4i, lo), __builtin_bit_cast(v4i, hi), 0, 1, 2, 3, 4, 5, 6, 7); }
struct Unit { int pm, pn; };
struct StaticOrder {
    int nM, nN, nwg, G, c;
    __device__ void init(int M, int N, int G_, int c_) { nM = M / BM; nN = N / BM; nwg = nM * nN; G = G_; c = c_; }
    __device__ bool next(int i, Unit& u) const {
        const long L = (long)i * G + c; if (L >= nwg) return false;
        int wgid = (int)L; { const int q = nwg / NXCD, r = nwg % NXCD, xcd = wgid % NXCD, off = wgid / NXCD; wgid = (xcd < r ? xcd * (q + 1) : r * (q + 1) + (xcd - r) * q) + off; }
        const int nig = WGM * nN, gid = wgid / nig, fm = gid * WGM, gsz = (nM - fm) < WGM ? (nM - fm) : WGM;
        u.pm = fm + ((wgid % nig) % gsz); u.pn = (wgid % nig) / gsz; return true;
    }
};
template <class Epi, class Prob>
__device__ __forceinline__ void gemm_phase(LAS unsigned char* lds, const Prob& P, const Epi& E, const int wid) {
    const int lane = lane_fresh(), tid = wid * 64 + lane, wr = wid >> 2, wc = wid & 3, fr = lane & 15, fq = lane >> 4;
    constexpr bool F8 = Prob::FP8;
    constexpr int KB = F8 ? 1024 : 2048, nt = KB / 128;
    constexpr bool GA = Prob::GATHER; constexpr bool B16 = Prob::B16;
    constexpr size_t rstepB = (size_t)(B16 ? 128 : 64) * KB, hstepB = (size_t)(B16 ? 8 : HALF) * KB;
    unsigned voB, voA; int gR0; unsigned gC2; const size_t rstep64 = (size_t)64 * KB;
    { int R0, C0; stage_rc(tid * 16, R0, C0); voA = (unsigned)(R0 * KB + C0 * 2); gR0 = R0; gC2 = (unsigned)C0 * 2u;
      const int Rb0 = B16 ? 64 * (R0 >> 5) + 16 * ((R0 & 15) >> 2) + 4 * ((R0 >> 4) & 1) + (R0 & 3) : (R0 & ~31) + perm32(R0 & 31); voB = (unsigned)(Rb0 * KB + C0 * 2); }
    const size_t kstep = (size_t)(BK * 2), hstep = (size_t)HALF * KB;
    const unsigned ldsw = (unsigned)wid * 1024u;
    const int aoff = lds_byte(wr * 64 + fr, fq * 8), boff = lds_byte(wc * 32 + fr, fq * 8);
#define PG8_SA(b, h) (((b) * 2 + (h)) * HTB)
#define PG8_SB(b, h) ((4 + (b) * 2 + (h)) * HTB)
#define PG8_STAGE2(bufoff, gbase, vo0, vo1) do { \
        __builtin_amdgcn_global_load_lds((const unsigned*)((const char*)(gbase) + (vo0)), (LAS unsigned*)(lds + (bufoff) + ldsw), 16, 0, 0); \
        __builtin_amdgcn_global_load_lds((const unsigned*)((const char*)(gbase) + (vo1)), (LAS unsigned*)(lds + (bufoff) + ldsw + 8192), 16, 0, 0); } while (0)
#define PG8_STAGE(bufoff, gbase, vo) do { \
        __builtin_amdgcn_global_load_lds((const unsigned*)((const char*)(gbase) + (vo)), (LAS unsigned*)(lds + (bufoff) + ldsw), 16, 0, 0); \
        __builtin_amdgcn_global_load_lds((const unsigned*)((const char*)(gbase) + rstep64 + (vo)), (LAS unsigned*)(lds + (bufoff) + ldsw + 8192), 16, 0, 0); } while (0)
#define PG8_STAGEB(bufoff, gbase) do { \
        __builtin_amdgcn_global_load_lds((const unsigned*)((const char*)(gbase) + (voB)), (LAS unsigned*)(lds + (bufoff) + ldsw), 16, 0, 0); \
        __builtin_amdgcn_global_load_lds((const unsigned*)((const char*)(gbase) + rstepB + (voB)), (LAS unsigned*)(lds + (bufoff) + ldsw + 8192), 16, 0, 0); } while (0)
#define PG8_GOFF(UIX, h) do { if constexpr (GA) { const LAS unsigned* _gp = P.goff + (UIX) * 256 + (h) * 128 + gR0; go0 = _gp[0]; go1 = _gp[64]; } } while (0)
#define PG8_STAGE_A(bufoff, gbase, UIX, h) do { if constexpr (GA) { const unsigned _v0 = go0 + gC2, _v1 = go1 + gC2; PG8_STAGE2(bufoff, gbase, _v0, _v1); } \
        else { PG8_STAGE(bufoff, (gbase) + (size_t)(h) * hstep, voA); } } while (0)
#define PG8_LDA(dst, b, h) do { _Pragma("unroll") for (int m = 0; m < 4; ++m) { const bf16x8 lo_ = *(const LAS bf16x8*)(lds + PG8_SA(b, h) + aoff + m * 2048), hi_ = *(const LAS bf16x8*)(lds + PG8_SA(b, h) + aoff + m * 2048 + 1024); \
        if constexpr (F8) dst##8[m] = cat8(lo_, hi_); else { dst[m][0] = lo_; dst[m][1] = hi_; } } } while (0)
#define PG8_LDB(dst, b, h) do { _Pragma("unroll") for (int n = 0; n < 2; ++n) { const bf16x8 lo_ = *(const LAS bf16x8*)(lds + PG8_SB(b, h) + boff + n * 2048), hi_ = *(const LAS bf16x8*)(lds + PG8_SB(b, h) + boff + n * 2048 + 1024); \
        if constexpr (F8) dst##8[n] = cat8(lo_, hi_); else { dst[n][0] = lo_; dst[n][1] = hi_; } } } while (0)
#define PG8_MMA(ai, bj, At, Bt) do { __builtin_amdgcn_s_setprio(1); _Pragma("unroll") for (int m = 0; m < 4; ++m) _Pragma("unroll") for (int n = 0; n < 2; ++n) { \
        if constexpr (F8) asm volatile("v_mfma_f32_16x16x128_f8f6f4 %0, %1, %2, %0" : "+v"(acc[ai][bj][m][n]) : "v"(Bt##8[n]), "v"(At##8[m])); \
        else { _Pragma("unroll") for (int k = 0; k < 2; ++k) acc[ai][bj][m][n] = __builtin_amdgcn_mfma_f32_16x16x32_bf16(Bt[n][k], At[m][k], acc[ai][bj][m][n], 0, 0, 0); } } \
        __builtin_amdgcn_s_setprio(0); } while (0)
#define PG8_WAIT_V(n) asm volatile("s_waitcnt vmcnt(" #n ")" ::: "memory")
#define PG8_WAIT_L(n) asm volatile("s_waitcnt lgkmcnt(" #n ")" ::: "memory")
#define PG8_BAR __builtin_amdgcn_s_barrier()
#define PG8_SCHED __builtin_amdgcn_sched_barrier(0)
#define PG8_BODY(VA1, VAX) do { \
            PG8_GOFF(VA1, 1); PG8_LDB(B0, 0, 0); PG8_LDB(B1, 0, 1); PG8_SCHED; PG8_LDA(At, 0, 0); PG8_STAGE_A(PG8_SA(1, 1), a1, VA1, 1); \
            PG8_WAIT_V(8); PG8_WAIT_L(0); PG8_BAR; PG8_MMA(0, 0, At, B0); PG8_MMA(0, 1, At, B1); PG8_BAR; PG8_SCHED; \
            PG8_GOFF(VAX, 0); PG8_LDA(At, 0, 1); PG8_STAGEB(PG8_SB(0, 0), b2); PG8_STAGEB(PG8_SB(0, 1), b2 + hstepB); PG8_STAGE_A(PG8_SA(0, 0), a2, VAX, 0); \
            PG8_WAIT_V(8); PG8_WAIT_L(0); PG8_BAR; PG8_MMA(1, 0, At, B0); PG8_MMA(1, 1, At, B1); PG8_BAR; PG8_SCHED; \
            PG8_GOFF(VAX, 1); PG8_LDB(B0, 1, 0); PG8_LDB(B1, 1, 1); PG8_SCHED; PG8_LDA(At, 1, 0); PG8_STAGE_A(PG8_SA(0, 1), a2, VAX, 1); \
            PG8_WAIT_V(8); PG8_WAIT_L(0); PG8_BAR; PG8_MMA(0, 0, At, B0); PG8_MMA(0, 1, At, B1); PG8_BAR; PG8_SCHED; \
            PG8_GOFF(VAX, 0); PG8_LDA(At, 1, 1); PG8_STAGEB(PG8_SB(1, 0), b3); PG8_STAGEB(PG8_SB(1, 1), b3 + hstepB); PG8_STAGE_A(PG8_SA(1, 0), a3, VAX, 0); \
            PG8_WAIT_V(8); PG8_WAIT_L(0); PG8_BAR; PG8_MMA(1, 0, At, B0); PG8_MMA(1, 1, At, B1); PG8_BAR; PG8_SCHED; } while (0)
    LAS int* utab = (LAS int*)(lds + UTAB_OFF);
    if (tid <= MAXU) { Unit t; const bool ok = (tid < MAXU) && P.next(tid, t); utab[tid] = ok ? (t.pm | (t.pn << 16)) : -1; }
    __syncthreads();
    Unit cur, nxt; nxt.pm = 0; nxt.pn = 0; int ui = 0;
    { const int e = __builtin_amdgcn_readfirstlane(utab[0]); if (e < 0) return; cur.pm = e & 0xffff; cur.pn = e >> 16; }
    f32x4 acc[2][2][4][2];
#pragma unroll
    for (int a = 0; a < 2; ++a)
#pragma unroll
        for (int b = 0; b < 2; ++b)
#pragma unroll
            for (int m = 0; m < 4; ++m)
#pragma unroll
                for (int n = 0; n < 2; ++n) acc[a][b][m][n] = (f32x4){0.f, 0.f, 0.f, 0.f};
    bf16x8 At[4][2], B0[2][2], B1[2][2]; v8i At8[4], B08[2], B18[2];
    const char* cA = P.a_base(cur); const char* cB = P.b_base(cur);
    unsigned go0 = 0u, go1 = 0u;
    PG8_STAGEB(PG8_SB(0, 0), cB); PG8_STAGEB(PG8_SB(0, 1), cB + hstepB); PG8_GOFF(0, 0); PG8_STAGE_A(PG8_SA(0, 0), cA, 0, 0); PG8_GOFF(0, 1); PG8_STAGE_A(PG8_SA(0, 1), cA, 0, 1);
    if (wr == 1) PG8_BAR;
    PG8_WAIT_V(2); PG8_BAR;
    PG8_STAGEB(PG8_SB(1, 0), cB + kstep); PG8_GOFF(0, 0); PG8_STAGE_A(PG8_SA(1, 0), cA + kstep, 0, 0); PG8_STAGEB(PG8_SB(1, 1), cB + hstepB + kstep);
    PG8_WAIT_V(6); PG8_BAR;
    for (;;) {
        const int en = __builtin_amdgcn_readfirstlane(utab[ui + 1]); const bool has_next = en >= 0; nxt.pm = en & 0xffff; nxt.pn = (en >> 16) & 0xffff;
        const char* nA = has_next ? P.a_base(nxt) : cA; const char* nB = has_next ? P.b_base(nxt) : cB;
        int ntr = nt - 2; asm volatile("" : "+s"(ntr));
#pragma nounroll
        for (int t = 0; t < ntr; t += 2) {
            const char* a1 = cA + (size_t)(t + 1) * kstep;
            const char* a2 = cA + (size_t)(t + 2) * kstep; const char* b2 = cB + (size_t)(t + 2) * kstep;
            const char* a3 = a2 + kstep; const char* b3 = b2 + kstep;
            PG8_BODY(ui, ui);
        }
        {
            const char* a1 = cA + (size_t)(nt - 1) * kstep;
            const char* a2 = nA; const char* b2 = nB; const char* a3 = a2 + kstep; const char* b3 = b2 + kstep;
            const int uin = has_next ? ui + 1 : ui;
            PG8_BODY(ui, uin);
        }
        if constexpr (F8) asm volatile("s_nop 15\n\ts_nop 15" ::: "memory");
        if (PG8_ALIGN_EPI) { if (wr == 0) PG8_BAR; }
        { const int le = lane_fresh(); E(acc, cur, wr, wc, le & 15, le >> 4, ui); }
        if (!has_next) break;
#pragma unroll
        for (int a = 0; a < 2; ++a)
#pragma unroll
            for (int b = 0; b < 2; ++b)
#pragma unroll
                for (int m = 0; m < 4; ++m)
#pragma unroll
                    for (int n = 0; n < 2; ++n) acc[a][b][m][n] = (f32x4){0.f, 0.f, 0.f, 0.f};
        cur = nxt; cA = nA; cB = nB; ++ui;
        if (PG8_ALIGN_EPI) { if (wr == 1) PG8_BAR; }
    }
    PG8_WAIT_V(0);
    if (!PG8_ALIGN_EPI) { if (wr == 0) PG8_BAR; }
    PG8_BAR;
#undef PG8_BODY
#undef PG8_SA
#undef PG8_SB
#undef PG8_STAGE
#undef PG8_STAGE2
#undef PG8_STAGEB
#undef PG8_STAGE_A
#undef PG8_GOFF
#undef PG8_LDA
#undef PG8_LDB
#undef PG8_MMA
#undef PG8_WAIT_V
#undef PG8_WAIT_L
#undef PG8_BAR
#undef PG8_SCHED
}
}

struct PbPlain : pg8::StaticOrder {
    const bf16* A; const bf16* Bt; int K;
    __device__ __forceinline__ const char* a_base(const pg8::Unit& u) const { return (const char*)(A + (size_t)u.pm * 256 * K); }
    __device__ __forceinline__ const char* b_base(const pg8::Unit& u) const { return (const char*)(Bt + (size_t)u.pn * 256 * K); }
    static constexpr bool GATHER = false, FP8 = false, B16 = false; LAS const unsigned* goff;
};
constexpr int GOFF_OFF = 131072;
__device__ __forceinline__ int pair_token(int t, int r) { if (r < 128) return 128 * t + r; const int sp = 128 * t + r - 128; return sp == 0 ? 1024 : SEQ - sp; }
struct PbDft {
    const bf16* T; const bf16* ET; const bf16* OT; int K, G, c; LAS const unsigned* goff;
    static constexpr bool GATHER = false, FP8 = false, B16 = false;
    __device__ __forceinline__ bool next(int i, pg8::Unit& u) const { const int L = (i >> 1) * G + c; if (L >= 256) return false; u.pm = (L >> 6) + 4 * (i & 1); u.pn = L & 63; return true; }
    __device__ __forceinline__ const char* a_base(const pg8::Unit& u) const { return (const char*)(T + (size_t)u.pm * 256 * K); }
    __device__ __forceinline__ const char* b_base(const pg8::Unit& u) const { return (const char*)((u.pm < 4 ? ET : OT) + (size_t)u.pn * 256 * K); }
};

struct PbMoe1 {
    const unsigned char* H2; const unsigned char* WGU; LAS const unsigned* goff; int K, G, c;
    __device__ __forceinline__ bool next(int i, pg8::Unit& u) const { const int L = i * G + c; if (L >= NPAIR * 8) return false;
        const int e = L >> 8, w = L & 255, x = w & 7, j = w >> 3, b = (j >> 3) * 8 + x; u.pm = b * 16 + e; u.pn = j & 7; return true; }
    __device__ __forceinline__ const char* a_base(const pg8::Unit&) const { return (const char*)H2; }
    __device__ __forceinline__ const char* b_base(const pg8::Unit& u) const { return (const char*)(WGU + ((size_t)(u.pm & 15) * 2048 + u.pn * 256) * 1024); }
    static constexpr bool GATHER = true, FP8 = true, B16 = false;
};
struct PbMoe2 {
    const unsigned char* ACT; const unsigned char* WD; int K, G, c;
    __device__ __forceinline__ bool next(int i, pg8::Unit& u) const { const int L = i * G + c; if (L >= NPAIR * 4) return false;
        const int e = L >> 7, w = L & 127, x = w & 7, j = w >> 3, b = (j >> 2) * 8 + x; u.pm = b * 16 + e; u.pn = j & 3; return true; }
    __device__ __forceinline__ const char* a_base(const pg8::Unit& u) const { return (const char*)(ACT + (size_t)u.pm * 256 * 1024); }
    __device__ __forceinline__ const char* b_base(const pg8::Unit& u) const { return (const char*)(WD + ((size_t)(u.pm & 15) * 1024 + u.pn * 256) * 1024); }
    static constexpr bool GATHER = false, FP8 = true, B16 = true; LAS const unsigned* goff;
};
typedef f32x4 AccT[2][2][4][2];
__device__ __forceinline__ v4u pack8(const f32x4& a, const f32x4& b) { v4u w; w.x = pk2(a.x, a.y); w.y = pk2(a.z, a.w); w.z = pk2(b.x, b.y); w.w = pk2(b.z, b.w); return w; }
struct EpiInProj { LAS unsigned char* lds;
    __device__ __forceinline__ void operator()(const AccT& acc, const pg8::Unit& u, int wr, int wc, int fr, int fq, int) const {
        KArgs ka = kargs(); unsigned char* ws = ka->ws;
        bf16* ET = (bf16*)(ws + WS_ET); bf16* OT = (bf16*)(ws + WS_OT); float* U1024 = (float*)(ws + WS_U1024); const bf16* MAT = (const bf16*)(ws + WS_MAT); const bf16* MBT = (const bf16*)(ws + WS_MBT);
        bf16* Q = (bf16*)(ws + WS_Q); bf16* Kb = (bf16*)(ws + WS_K); bf16* V = (bf16*)(ws + WS_V); const float* qg = ka->in[I_QG]; const float* kg = ka->in[I_KG];
        const int b = u.pm >> 3, t = u.pm & 7;
        if (u.pn < 2) {
            const int gg = 4 * u.pn + wc;
            const bf16* ma = MAT + gg * 4096 + fr * 64 + 8 * fq; const bf16* mb = MBT + gg * 4096 + fr * 64 + 8 * fq;
            bf16x8 fa[4][2], fb[4][2];
#pragma unroll
            for (int db = 0; db < 4; ++db) { fa[db][0] = *(const bf16x8*)(ma + db * 1024); fa[db][1] = *(const bf16x8*)(ma + db * 1024 + 32); fb[db][0] = *(const bf16x8*)(mb + db * 1024); fb[db][1] = *(const bf16x8*)(mb + db * 1024 + 32); }
            LAS unsigned short* tile = (LAS unsigned short*)(lds + GOFF_OFF + 8192 + (wr * 4 + wc) * 1024);
            const int l64 = fr + 16 * fq, dd = l64 >> 2, chn = l64 & 3;
#pragma unroll
            for (int mp = 0; mp < 2; ++mp) {
                bf16x8 ef[2][2], of[2][2], uf[2];
#pragma unroll
                for (int mm = 0; mm < 2; ++mm) { const int m = 2 * mp + mm; const bool tok0 = (t == 0 && wr == 0 && m == 0 && fr == 0);
#pragma unroll
                    for (int bj = 0; bj < 2; ++bj) { f32x4 e0 = acc[0][bj][m][0] + acc[1][bj][m][0], e1 = acc[0][bj][m][1] + acc[1][bj][m][1], o0 = acc[0][bj][m][0] - acc[1][bj][m][0], o1 = acc[0][bj][m][1] - acc[1][bj][m][1];
                        if (tok0) { e0 = acc[0][bj][m][0]; e1 = acc[0][bj][m][1]; o0 = (f32x4){0.f, 0.f, 0.f, 0.f}; o1 = o0; }
                        ef[mm][bj] = __builtin_bit_cast(bf16x8, pack8(e0, e1)); of[mm][bj] = __builtin_bit_cast(bf16x8, pack8(o0, o1));
                        if (m == 0) uf[bj] = __builtin_bit_cast(bf16x8, pack8(acc[1][bj][0][0], acc[1][bj][0][1])); } }
#pragma unroll
                for (int db = 0; db < 4; ++db) {
                    f32x4 em[2], om[2];
#pragma unroll
                    for (int mm = 0; mm < 2; ++mm) { em[mm] = (f32x4){0.f, 0.f, 0.f, 0.f}; om[mm] = em[mm];
                        em[mm] = __builtin_amdgcn_mfma_f32_16x16x32_bf16(fa[db][0], ef[mm][0], em[mm], 0, 0, 0); em[mm] = __builtin_amdgcn_mfma_f32_16x16x32_bf16(fa[db][1], ef[mm][1], em[mm], 0, 0, 0);
                        om[mm] = __builtin_amdgcn_mfma_f32_16x16x32_bf16(fb[db][0], of[mm][0], om[mm], 0, 0, 0); om[mm] = __builtin_amdgcn_mfma_f32_16x16x32_bf16(fb[db][1], of[mm][1], om[mm], 0, 0, 0); }
                    const unsigned o = (unsigned)(((unsigned)b * 512u + gg * 64 + 16 * db + dd) * 1024u + 128 * t + wr * 64 + 32 * mp + 8 * chn);
                    LAS unsigned short* tw = tile + (4 * fq) * 32 + fr;
                    tw[0] = (unsigned short)f2bf(em[0].x); tw[32] = (unsigned short)f2bf(em[0].y); tw[64] = (unsigned short)f2bf(em[0].z); tw[96] = (unsigned short)f2bf(em[0].w);
                    tw[16] = (unsigned short)f2bf(em[1].x); tw[48] = (unsigned short)f2bf(em[1].y); tw[80] = (unsigned short)f2bf(em[1].z); tw[112] = (unsigned short)f2bf(em[1].w);
                    asm volatile("" ::: "memory");
                    { const v4u ve = *(const LAS v4u*)(tile + dd * 32 + 8 * chn); asm volatile("" ::: "memory"); *(v4u*)(ET + o) = ve; }
                    tw[0] = (unsigned short)f2bf(om[0].x); tw[32] = (unsigned short)f2bf(om[0].y); tw[64] = (unsigned short)f2bf(om[0].z); tw[96] = (unsigned short)f2bf(om[0].w);
                    tw[16] = (unsigned short)f2bf(om[1].x); tw[48] = (unsigned short)f2bf(om[1].y); tw[80] = (unsigned short)f2bf(om[1].z); tw[112] = (unsigned short)f2bf(om[1].w);
                    asm volatile("" ::: "memory");
                    { const v4u vo = *(const LAS v4u*)(tile + dd * 32 + 8 * chn); asm volatile("" ::: "memory"); *(v4u*)(OT + o) = vo; }
                    if (mp == 0 && t == 0 && wr == 0) {
                        f32x4 um = {0.f, 0.f, 0.f, 0.f};
                        um = __builtin_amdgcn_mfma_f32_16x16x32_bf16(fa[db][0], uf[0], um, 0, 0, 0); um = __builtin_amdgcn_mfma_f32_16x16x32_bf16(fa[db][1], uf[1], um, 0, 0, 0);
                        if (fr == 0) *(f32x4*)(U1024 + b * 512 + gg * 64 + 16 * db + 4 * fq) = um; }
                } }
        } else {
            const int hg = (u.pn - 2) * 4 + wc;
            const bool isq = hg < 8, isk = (hg >= 8 && hg < 10);
            const float* gain = isq ? qg : kg;
            f32x4 gv[2][2];
#pragma unroll
            for (int bj = 0; bj < 2; ++bj)
#pragma unroll
                for (int n = 0; n < 2; ++n) gv[bj][n] = *(const f32x4*)(gain + 32 * bj + 8 * fq + 4 * n);
            bf16* base; int ld, hoff;
            if (isq) { base = Q; ld = 512; hoff = hg * 64; } else if (isk) { base = Kb; ld = 128; hoff = (hg - 8) * 64; } else { base = V; ld = 128; hoff = (hg - 10) * 64; }
#pragma unroll
            for (int ai = 0; ai < 2; ++ai)
#pragma unroll
                for (int m = 0; m < 4; ++m) { float ss = 0.f;
#pragma unroll
                    for (int bj = 0; bj < 2; ++bj)
#pragma unroll
                        for (int n = 0; n < 2; ++n) { const f32x4 v = acc[ai][bj][m][n]; ss += (v.x * v.x + v.y * v.y) + (v.z * v.z + v.w * v.w); }
                    ss += __shfl_xor(ss, 16); ss += __shfl_xor(ss, 32);
                    const float rs = (isq || isk) ? 1.f / sqrtf(ss * (1.f / 64.f) + EPS) : 1.f;
                    const int tok = b * SEQ + pair_token(t, ai * 128 + wr * 64 + m * 16 + fr);
                    bf16* rowp = base + (unsigned)((unsigned)tok * ld + hoff + 8 * fq);
#pragma unroll
                    for (int bj = 0; bj < 2; ++bj) { f32x4 v0 = acc[ai][bj][m][0] * rs, v1 = acc[ai][bj][m][1] * rs; if (isq || isk) { v0 = v0 * gv[bj][0]; v1 = v1 * gv[bj][1]; } *(v4u*)(rowp + 32 * bj) = pack8(v0, v1); } }
        }
    }
};
struct EpiDft {
    __device__ __forceinline__ void operator()(const AccT& acc, const pg8::Unit& u, int wr, int wc, int fr, int fq, int) const {
        KArgs ka = kargs(); unsigned char* ws = ka->ws; bf16* Y = (bf16*)(ws + WS_Y); float* PA = (float*)(ws + WS_PA); const float* U1024 = (const float*)(ws + WS_U1024); const float* bfv = ka->in[I_BF];
        const int b = u.pn >> 1; const bool cosr = u.pm < 4; const float sgn = (fr & 1) ? -1.f : 1.f;
        float* pa = PA + (size_t)((u.pm & 3) * 64 + u.pn) * 65536;
        bf16* yb = Y + (unsigned)((unsigned)b * SEQ * KOUT);
#pragma unroll
        for (int bj = 0; bj < 2; ++bj) { const int cl = bj * 128 + wc * 32 + 8 * fq, ch = (u.pn & 1) * 256 + cl;
            f32x4 ua, ub;
            if (cosr) { ua = *(const f32x4*)(U1024 + b * 512 + ch) * sgn; ub = *(const f32x4*)(U1024 + b * 512 + ch + 4) * sgn; }
            else { ua = *(const f32x4*)(bfv + ch); ub = *(const f32x4*)(bfv + ch + 4); }
#pragma unroll
            for (int ai = 0; ai < 2; ++ai)
#pragma unroll
                for (int m = 0; m < 4; ++m) { const int rl = ai * 128 + wr * 64 + m * 16 + fr, k = (u.pm & 3) * 256 + rl;
                    float* pp = pa + rl * 256 + cl;
                    if (cosr) { *(f32x4*)pp = acc[ai][bj][m][0] + ua; *(f32x4*)(pp + 4) = acc[ai][bj][m][1] + ub; }
                    else { const f32x4 p0 = *(const f32x4*)pp + ua, p1 = *(const f32x4*)(pp + 4) + ub;
                        *(v4u*)(yb + (unsigned)(k * KOUT + ch)) = pack8(p0 + acc[ai][bj][m][0], p1 + acc[ai][bj][m][1]);
                        if (k > 0) *(v4u*)(yb + (unsigned)((SEQ - k) * KOUT + ch)) = pack8(p0 - acc[ai][bj][m][0], p1 - acc[ai][bj][m][1]); } } }
    }
};
struct EpiOut {
    __device__ __forceinline__ void operator()(const AccT& acc, const pg8::Unit& u, int wr, int wc, int fr, int fq, int) const {
        KArgs ka = kargs(); unsigned char* ws = ka->ws; bf16* DELTA = (bf16*)(ws + WS_DELTA);
        const int row0 = u.pm * 256 + wr * 64 + fr, b = row0 / SEQ, col0 = u.pn * 256 + wc * 32 + 8 * fq;
        const float* g1p = (const float*)(ws + WS_MOD) + b * NADA + 2 * DM + col0;
#pragma unroll
        for (int bj = 0; bj < 2; ++bj) { const f32x4 ga = *(const f32x4*)(g1p + bj * 128), gb = *(const f32x4*)(g1p + bj * 128 + 4);
#pragma unroll
            for (int ai = 0; ai < 2; ++ai)
#pragma unroll
                for (int m = 0; m < 4; ++m) { const unsigned off = (unsigned)(row0 + ai * 128 + m * 16) * DM + col0;
                    __builtin_nontemporal_store(pack8(ga * acc[ai][bj][m][0], gb * acc[ai][bj][m][1]), (v4u*)(DELTA + off + bj * 128)); } }
    }
};
__device__ __forceinline__ float silu_mul(float g, float u) { return g * u * __builtin_amdgcn_rcpf(1.f + __builtin_amdgcn_exp2f(-LOG2E * g)); }
struct EpiSwiGLU { static constexpr bool SPLIT = false;
    __device__ __forceinline__ void operator()(const AccT& acc, const pg8::Unit& u, int wr, int wc, int fr, int fq, int) const {
        unsigned char* ACT = kargs()->ws + WS_ACT;
#pragma unroll
        for (int ai = 0; ai < 2; ++ai)
#pragma unroll
            for (int mp = 0; mp < 2; ++mp) { v2u w[2];
#pragma unroll
                for (int mm = 0; mm < 2; ++mm) { const int m = 2 * mp + mm; f32x4 o[2];
#pragma unroll
                    for (int n = 0; n < 2; ++n) { const f32x4 g = acc[ai][0][m][n] * W8I, up = acc[ai][1][m][n] * W8I;
#pragma unroll
                        for (int j = 0; j < 4; ++j) o[n][j] = silu_mul(g[j], up[j]); }
                    w[mm].x = pk4_fp8(o[0].x, o[0].y, o[0].z, o[0].w); w[mm].y = pk4_fp8(o[1].x, o[1].y, o[1].z, o[1].w); }
                const v2u sx = __builtin_amdgcn_permlane16_swap(w[0].x, w[1].x, false, false), sy = __builtin_amdgcn_permlane16_swap(w[0].y, w[1].y, false, false);
                v4u ov; ov.x = sx[0]; ov.y = sy[0]; ov.z = sx[1]; ov.w = sy[1];
                unsigned char* rowp = ACT + (unsigned)(((unsigned)u.pm * 256u + (unsigned)(ai * 128 + wr * 64 + (2 * mp + (fq & 1)) * 16 + fr)) * DEXP + u.pn * 128 + wc * 32 + 16 * (fq >> 1));
                __builtin_nontemporal_store(ov, (v4u*)rowp); }
    }
};
struct EpiY { static constexpr bool SPLIT = false; LAS const float* gate;
    __device__ __forceinline__ void operator()(const AccT& acc, const pg8::Unit& u, int wr, int wc, int fr, int fq, int ui) const {
        unsigned char* YB = kargs()->ws + WS_YB;
#pragma unroll
        for (int ai = 0; ai < 2; ++ai)
#pragma unroll
            for (int m = 0; m < 4; ++m) { const int rl = ai * 128 + wr * 64 + m * 16 + fr; const float gt = gate[ui * 256 + rl]; unsigned char* rowp = YB + (unsigned)(((unsigned)u.pm * 256u + (unsigned)rl) * DM + u.pn * 256 + wc * 64 + 16 * fq);
                const f32x4 v0 = acc[ai][0][m][0] * gt, v1 = acc[ai][0][m][1] * gt, v2 = acc[ai][1][m][0] * gt, v3 = acc[ai][1][m][1] * gt; v4u w;
                w.x = pk4_fp8(v0.x, v0.y, v0.z, v0.w); w.y = pk4_fp8(v1.x, v1.y, v1.z, v1.w); w.z = pk4_fp8(v2.x, v2.y, v2.z, v2.w); w.w = pk4_fp8(v3.x, v3.y, v3.z, v3.w);
                __builtin_nontemporal_store(w, (v4u*)rowp); }
    }
};

typedef float f32x16 __attribute__((ext_vector_type(16)));
constexpr int AT_KL = 0, AT_KSTRIDE = 144;
constexpr int AT_VT = 384 * 144, AT_VSTRIDE = 776;
constexpr int AT_TB = AT_VT + 64 * 776;
__device__ __forceinline__ void attn_phase(KArgs a, LAS unsigned char* lds, int tid, int wave, int lane, int G) {
    const bf16* Q = (const bf16*)(a->ws + WS_Q); const bf16* Kb = (const bf16*)(a->ws + WS_K); const bf16* V = (const bf16*)(a->ws + WS_V); bf16* Y = (bf16*)(a->ws + WS_Y);
    LAS float* TB = (LAS float*)(lds + AT_TB);
    for (int i = tid; i < 8 * 257; i += NTHR) { const int h = i / 257, ii = i % 257; TB[h * 260 + ii] = a->in[I_RELB][t5_bucket(ii - 128) * 8 + h] * 8.f; }
    const int l31 = lane & 31, hh = lane >> 5;
    const float c1 = 0.125f * LOG2E;
    for (int it = blockIdx.x; it < NB * 2 * 4; it += G) {
        const int b = it >> 3, kh = (it >> 2) & 1, qs0 = (it & 3) * 512;
        __syncthreads();
        for (int c = tid; c < 3072; c += NTHR) { const int r = c >> 3, ch = c & 7, key = qs0 - 128 + r; v4u val = {0u, 0u, 0u, 0u};
            if (key >= 0 && key < SEQ) val = *(const v4u*)(Kb + ((size_t)b * SEQ + key) * 128 + kh * 64 + ch * 8);
            *(LAS v4u*)(lds + AT_KL + r * AT_KSTRIDE + ch * 16) = val; }
        for (int c = tid; c < 1536; c += NTHR) { const int kp = c % 192, cd = c / 192, r = 2 * kp, key = qs0 - 128 + r; v4u v0 = {0u, 0u, 0u, 0u}, v1 = {0u, 0u, 0u, 0u};
            if (key >= 0 && key < SEQ) { const bf16* vp = V + ((size_t)b * SEQ + key) * 128 + kh * 64 + cd * 8; v0 = *(const v4u*)vp; v1 = *(const v4u*)(vp + 128); }
            const unsigned w0[4] = {v0.x, v0.y, v0.z, v0.w}, w1[4] = {v1.x, v1.y, v1.z, v1.w};
#pragma unroll
            for (int j = 0; j < 4; ++j) {
                *(LAS unsigned*)(lds + AT_VT + (8 * cd + 2 * j) * AT_VSTRIDE + r * 2) = (w0[j] & 0xffffu) | (w1[j] << 16);
                *(LAS unsigned*)(lds + AT_VT + (8 * cd + 2 * j + 1) * AT_VSTRIDE + r * 2) = (w0[j] >> 16) | (w1[j] & 0xffff0000u); } }
        __syncthreads();
      for (int bi = 0; bi < 4; ++bi) {
        const int qs = qs0 + 128 * bi;
        const int nkey0 = qs0 + 256 + 128 * bi;
        v4u pk0 = {0u, 0u, 0u, 0u}, pk1 = pk0, pv0 = pk0, pv1 = pk0;
        if (bi < 3 && nkey0 < SEQ) { const bf16* kp_ = Kb + ((size_t)b * SEQ + nkey0 + (tid >> 3)) * 128 + kh * 64 + (tid & 7) * 8; pk0 = *(const v4u*)kp_; pk1 = *(const v4u*)(kp_ + 64 * 128);
            const bf16* vp_ = V + ((size_t)b * SEQ + nkey0 + 2 * (tid & 63)) * 128 + kh * 64 + (tid >> 6) * 8; pv0 = *(const v4u*)vp_; pv1 = *(const v4u*)(vp_ + 128); }
        const int r4 = wave >> 1, half = wave & 1, hq = kh * 4 + r4, q0 = qs + 64 * half;
        bf16x8 qf[2][4];
#pragma unroll
        for (int j = 0; j < 2; ++j)
#pragma unroll
            for (int ks = 0; ks < 4; ++ks) qf[j][ks] = *(const bf16x8*)(Q + ((size_t)b * SEQ + q0 + 32 * j + l31) * 512 + hq * 64 + 16 * ks + 8 * hh);
        float mrun[2], lrun[2]; f32x16 O[2][2];
        { const float sk = a->in[I_SINK][hq] * LOG2E; mrun[0] = sk; mrun[1] = sk; lrun[0] = hh == 0 ? 1.f : 0.f; lrun[1] = lrun[0]; }
#pragma unroll
        for (int d = 0; d < 2; ++d)
#pragma unroll
            for (int j = 0; j < 2; ++j)
#pragma unroll
                for (int i = 0; i < 16; ++i) O[d][j][i] = 0.f;
        const LAS float* tbh = TB + hq * 260;
        for (int kk = 0; kk < 10; ++kk) {
            const int key0 = q0 - 128 + 32 * kk;
            if (key0 + 31 < 0 || key0 >= SEQ) continue;
            const int rel = 128 * bi + 64 * half + 32 * kk, lrow = ((rel >> 7) % 3) * 128 + (rel & 127);
            const bool edge = (key0 < 0) || (key0 + 31 >= SEQ);
            bf16x8 kf[4];
#pragma unroll
            for (int ks = 0; ks < 4; ++ks) kf[ks] = *(const LAS bf16x8*)(lds + AT_KL + (lrow + l31) * AT_KSTRIDE + (16 * ks + 8 * hh) * 2);
            bf16x8 pf[2][2]; bool live[2];
#pragma unroll
            for (int j = 0; j < 2; ++j) {
                const int dk = kk - j;
                live[j] = (dk >= 0 && dk <= 8);
                if (!live[j]) continue;
                f32x16 S;
                const int ib = 32 * dk - l31 + 4 * hh;
                const bool interior = (dk >= 1 && dk <= 7 && !edge);
                if (interior) { const LAS float* tp = tbh + ib;
#pragma unroll
                    for (int i = 0; i < 16; ++i) S[i] = tp[(i & 3) + 8 * (i >> 2)];
                } else { int ibm = ib; asm volatile("" : "+v"(ibm));
#pragma unroll
                    for (int i = 0; i < 16; ++i) { const int idx = ibm + (i & 3) + 8 * (i >> 2); S[i] = tbh[idx < 0 ? 0 : (idx > 256 ? 256 : idx)]; }
                }
#pragma unroll
                for (int ks = 0; ks < 4; ++ks) S = __builtin_amdgcn_mfma_f32_32x32x16_bf16(kf[ks], qf[j][ks], S, 0, 0, 0);
                if (!interior) { int ibm = ib, kb = key0 + 4 * hh; asm volatile("" : "+v"(ibm), "+v"(kb));
#pragma unroll
                    for (int i = 0; i < 16; ++i) { const int ro = (i & 3) + 8 * (i >> 2), idx = ibm + ro, key = kb + ro;
                        const bool valid = (idx >= 0) && (idx <= 256) && (key >= 0) && (key < SEQ); S[i] = valid ? S[i] : -INFINITY; }
                }
                float mx = S[0];
#pragma unroll
                for (int i = 1; i < 16; ++i) mx = fmaxf(mx, S[i]);
                mx = fmaxf(mx, __shfl_xor(mx, 32)) * c1;
                if (__any(mx > mrun[j] + 8.f)) {
                    const float mn = fmaxf(mrun[j], mx), al = __builtin_amdgcn_exp2f(mrun[j] - mn); mrun[j] = mn; lrun[j] *= al;
#pragma unroll
                    for (int d = 0; d < 2; ++d)
#pragma unroll
                        for (int i = 0; i < 16; ++i) O[d][j][i] *= al;
                }
                const float nm = -mrun[j]; float rs = 0.f;
#pragma unroll
                for (int i = 0; i < 16; ++i) { const float p = __builtin_amdgcn_exp2f(__builtin_fmaf(S[i], c1, nm)); S[i] = p; rs += p; }
                lrun[j] += rs;
#pragma unroll
                for (int s2 = 0; s2 < 2; ++s2) { v4u w; w.x = pk2(S[8 * s2], S[8 * s2 + 1]); w.y = pk2(S[8 * s2 + 2], S[8 * s2 + 3]); w.z = pk2(S[8 * s2 + 4], S[8 * s2 + 5]); w.w = pk2(S[8 * s2 + 6], S[8 * s2 + 7]); pf[j][s2] = __builtin_bit_cast(bf16x8, w); }
            }
#pragma unroll
            for (int d = 0; d < 2; ++d)
#pragma unroll
                for (int s2 = 0; s2 < 2; ++s2) { const LAS unsigned char* vp = lds + AT_VT + (32 * d + l31) * AT_VSTRIDE + (lrow + 16 * s2 + 4 * hh) * 2;
                    const v2u lo = *(const LAS v2u*)vp, hi = *(const LAS v2u*)(vp + 16); v4u w; w.x = lo.x; w.y = lo.y; w.z = hi.x; w.w = hi.y; const bf16x8 vf = __builtin_bit_cast(bf16x8, w);
#pragma unroll
                    for (int j = 0; j < 2; ++j) if (live[j]) O[d][j] = __builtin_amdgcn_mfma_f32_32x32x16_bf16(vf, pf[j][s2], O[d][j], 0, 0, 0); }
        }
#pragma unroll
        for (int j = 0; j < 2; ++j) { const float lt = lrun[j] + __shfl_xor(lrun[j], 32); const float inv = 1.f / lt;
            bf16* yp = Y + ((size_t)b * SEQ + q0 + 32 * j + l31) * KOUT + 512 + hq * 64 + 4 * hh;
#pragma unroll
            for (int d = 0; d < 2; ++d)
#pragma unroll
                for (int g4 = 0; g4 < 4; ++g4) { v2u w; w.x = pk2(O[d][j][4 * g4] * inv, O[d][j][4 * g4 + 1] * inv); w.y = pk2(O[d][j][4 * g4 + 2] * inv, O[d][j][4 * g4 + 3] * inv); *(v2u*)(yp + 32 * d + 8 * g4) = w; } }
        if (bi < 3) {
            __syncthreads();
            const int slot = bi % 3, r0 = slot * 128 + (tid >> 3);
            *(LAS v4u*)(lds + AT_KL + r0 * AT_KSTRIDE + (tid & 7) * 16) = pk0; *(LAS v4u*)(lds + AT_KL + (r0 + 64) * AT_KSTRIDE + (tid & 7) * 16) = pk1;
            const int cd = tid >> 6, rr = slot * 128 + 2 * (tid & 63); const unsigned w0[4] = {pv0.x, pv0.y, pv0.z, pv0.w}, w1[4] = {pv1.x, pv1.y, pv1.z, pv1.w};
#pragma unroll
            for (int j = 0; j < 4; ++j) {
                *(LAS unsigned*)(lds + AT_VT + (8 * cd + 2 * j) * AT_VSTRIDE + rr * 2) = (w0[j] & 0xffffu) | (w1[j] << 16);
                *(LAS unsigned*)(lds + AT_VT + (8 * cd + 2 * j + 1) * AT_VSTRIDE + rr * 2) = (w0[j] >> 16) | (w1[j] & 0xffff0000u); }
            __syncthreads();
        }
      }
    }
    __syncthreads();
}

__device__ __forceinline__ void ph2_inproj(KArgs args, LAS unsigned char* lds, int tid, int G, int bx, int wave) {
    unsigned char* ws = args->ws;
    PbPlain P; P.init(MTOK, NPROJ, G, bx); P.A = (const bf16*)(ws + WS_H); P.Bt = (const bf16*)(ws + WS_WIN); P.K = DM; P.goff = nullptr;
    EpiInProj E{lds};
    pg8::gemm_phase(lds, P, E, wave);
}
__device__ __forceinline__ void ph3_dft(KArgs args, LAS unsigned char* lds, int G, int bx, int wave, int lane, int vcu) {
    unsigned char* ws = args->ws;
    PbDft P; P.T = (const bf16*)(ws + WS_T); P.ET = (const bf16*)(ws + WS_ET); P.OT = (const bf16*)(ws + WS_OT); P.K = 1024; P.G = G; P.c = bx; P.goff = nullptr;
    EpiDft E;
    pg8::gemm_phase(lds, P, E, wave);
    { const bf16* ET = (const bf16*)(ws + WS_ET); const float* U1024 = (const float*)(ws + WS_U1024); const float* bfv = args->in[I_BF]; bf16* Y = (bf16*)(ws + WS_Y);
      const int gw = vcu * NWAVES + wave, NGW = G * NWAVES;
      for (int row0 = gw * 8; row0 < NB * 512; row0 += NGW * 8) {
          v4u d[8][2]; float sacc[8];
#pragma unroll
          for (int q = 0; q < 8; ++q) ld_row_bf(ET + (size_t)(row0 + q) * 1024, lane, d[q]);
#pragma unroll
          for (int q = 0; q < 8; ++q) { sacc[q] = 0.f;
#pragma unroll
              for (int h = 0; h < 2; ++h) sacc[q] += (bf2f(d[q][h].x & 0xffffu) - bf2f(d[q][h].x >> 16)) + (bf2f(d[q][h].y & 0xffffu) - bf2f(d[q][h].y >> 16)) + (bf2f(d[q][h].z & 0xffffu) - bf2f(d[q][h].z >> 16)) + (bf2f(d[q][h].w & 0xffffu) - bf2f(d[q][h].w >> 16)); }
#pragma unroll
          for (int o = 1; o < 64; o <<= 1) {
#pragma unroll
              for (int q = 0; q < 8; ++q) sacc[q] += __shfl_xor(sacc[q], o); }
          float mine = sacc[0];
#pragma unroll
          for (int q = 1; q < 8; ++q) mine = (lane == q) ? sacc[q] : mine;
          if (lane < 8) { const int row = row0 + lane; Y[((size_t)(row >> 9) * SEQ + 1024) * KOUT + (row & 511)] = (bf16)f2bf(mine + U1024[row] + bfv[row & 511]); } } }
}
__device__ __forceinline__ void ph4_out(KArgs args, LAS unsigned char* lds, int G, int bx, int wave) {
    unsigned char* ws = args->ws;
    PbPlain P; P.init(MTOK, DM, G, bx); P.A = (const bf16*)(ws + WS_Y); P.Bt = (const bf16*)(ws + WS_WOUT); P.K = KOUT;
    EpiOut E;
    pg8::gemm_phase(lds, P, E, wave);
}
__device__ __forceinline__ void ph7_moe1(KArgs args, LAS unsigned char* lds, int tid, int G, int bx, int wave) {
    unsigned char* ws = args->ws;
    PbMoe1 P; P.H2 = ws + WS_H2; P.WGU = ws + WS_WGU; P.goff = (LAS const unsigned*)(lds + GOFF_OFF); P.K = DM; P.G = G; P.c = bx;
    { const int* IDX = (const int*)(ws + WS_IDX); LAS unsigned* go = (LAS unsigned*)(lds + GOFF_OFF); pg8::Unit u;
      for (int i = 0; i < 16 && P.next(i, u); ++i) for (int r = tid; r < 256; r += NTHR) go[i * 256 + r] = (unsigned)(((u.pm >> 4) * SEQ + IDX[u.pm * CAP + r]) * DM);
      __syncthreads(); }
    EpiSwiGLU E;
    pg8::gemm_phase(lds, P, E, wave);
}
__device__ __forceinline__ void ph8_moe2(KArgs args, LAS unsigned char* lds, int G, int bx, int wave) {
    unsigned char* ws = args->ws;
    PbMoe2 P; P.ACT = ws + WS_ACT; P.WD = ws + WS_WD; P.goff = nullptr; P.K = DEXP; P.G = G; P.c = bx;
    { const float* GATE = (const float*)(ws + WS_GATE); LAS float* gl = (LAS float*)(lds + GOFF_OFF); pg8::Unit u;
      for (int i = 0; i < 8 && P.next(i, u); ++i) for (int r = wave * 64 + lane_fresh(); r < 256; r += NTHR) gl[i * 256 + r] = GATE[u.pm * CAP + r];
      __syncthreads(); }
    EpiY E{(LAS const float*)(lds + GOFF_OFF)};
    pg8::gemm_phase(lds, P, E, wave);
}

constexpr int LDSCTL_OFF = 147456;
constexpr int CW_BAR = 4096;
__global__ void __launch_bounds__(NTHR, 2) mega(Args args) {
    extern __shared__ __attribute__((aligned(16))) unsigned char lds_raw[];
    LAS unsigned char* lds = (LAS unsigned char*)lds_raw;
    const int wave = __builtin_amdgcn_readfirstlane(threadIdx.x >> 6);
#define LANE lane_fresh()
#define TID (wave * 64 + lane_fresh())
    const int G = gridDim.x; const int bx = blockIdx.x; const int vcu = (G % 8 == 0) ? (bx % 8) * (G / 8) + bx / 8 : bx;
    const int lo = args.ph_lo, hi = args.ph_hi;
    unsigned char* ws = args.ws;
    for (int u = TID; u < 128; u += NTHR) ((LAS unsigned*)(lds + LDSCTL_OFF))[u] = 0u;
    __syncthreads();
    XcdBarrier bar; bar.bar = (unsigned*)(ws + WS_CTL) + CW_BAR; bar.x = 0; bar.st = nullptr;
    if (hi - lo > 1) bar = xcd_barrier_post((unsigned*)(ws + WS_CTL) + CW_BAR, (volatile LAS unsigned*)(lds + LDSCTL_OFF), wave);
#ifndef PROBE_DUP
#define PROBE_DUP -1
#endif
#define IN(k) (lo <= (k) && (k) < hi)
#define SEAM(k) do { if (IN(k) && IN((k) + 1)) xcd_barrier(bar, wave); } while (0)
#define PHASE(k, ...) do { if (IN(k)) { __VA_ARGS__; if (PROBE_DUP == (k)) { xcd_barrier(bar, wave); __VA_ARGS__; } } SEAM(k); } while (0)
    PHASE(0, p0_mod(kargs(), lds, TID, G); p0_maps(kargs(), lds, TID, G); p0_rest(kargs(), lds, TID, wave, LANE, vcu, G));
    PHASE(1, p1_h(kargs(), wave, LANE, vcu, G));
    PHASE(2, ph2_inproj(kargs(), lds, TID, G, bx, wave));
    PHASE(3, if (kargs()->li != 2) ph3_dft(kargs(), lds, G, bx, wave, LANE, vcu); if (kargs()->li != 1) attn_phase(kargs(), lds, TID, wave, LANE, G));
    PHASE(4, ph4_out(kargs(), lds, G, bx, wave));
    PHASE(5, p5_router(kargs(), lds, TID, wave, LANE, vcu, G));
    PHASE(6, p6_topk(kargs(), lds, TID, G));
    PHASE(7, ph7_moe1(kargs(), lds, TID, G, bx, wave));
    PHASE(8, ph8_moe2(kargs(), lds, G, bx, wave));
    PHASE(9, p9_combine(kargs(), wave, LANE, vcu, G));
#undef PHASE
#undef IN
#undef SEAM
}

#ifndef MK_CUTS
#define MK_CUTS 1
#endif
extern "C" void kernel_launch(void* const* d_in, const int* in_sizes, int n_in, void* d_out, int out_size, void* d_ws, size_t ws_size, hipStream_t stream) {
    static int grid = 0;
    if (grid == 0) {
        if (n_in != 18 || in_sizes[0] != MTOK * DM || out_size != MTOK * DM || ws_size < WS_END) { fprintf(stderr, "kernel_launch: unexpected shapes (n_in %d, in0 %d, out %d, ws %zu)\n", n_in, n_in > 0 ? in_sizes[0] : -1, out_size, ws_size); grid = -1; return; }
        int dev = 0, cus = 0;
        if (hipGetDevice(&dev) != hipSuccess || hipDeviceGetAttribute(&cus, hipDeviceAttributeMultiprocessorCount, dev) != hipSuccess) { grid = -1; return; }
        if (hipFuncSetAttribute((const void*)mega, hipFuncAttributeMaxDynamicSharedMemorySize, LDS_BYTES) != hipSuccess) { fprintf(stderr, "kernel_launch: hipFuncSetAttribute failed\n"); grid = -1; return; }
        (void)hipGetLastError();
        grid = cus;
    }
    if (grid < 0) return;
    (void)hipMemsetAsync((char*)d_ws + WS_CTL, 0, 65536, stream);
    Args a{};
    for (int i = 0; i < 18; ++i) a.in[i] = (const float*)d_in[i];
    a.out = (float*)d_out; a.ws = (unsigned char*)d_ws;
    auto run = [&](int lo, int hi) { Args b = a; b.ph_lo = lo; b.ph_hi = hi; b.li = 0; hipLaunchKernelGGL(mega, dim3(grid), dim3(NTHR), LDS_BYTES, stream, b); };
#ifndef PROBE_HOST_DUP
#define PROBE_HOST_DUP -1
#endif
    if (MK_CUTS == 1) run(0, 10);
    else for (int p = 0; p < 10; ++p) { run(p, p + 1);
        if (PROBE_HOST_DUP == p) run(p, p + 1);
        if (p == 3 && (PROBE_HOST_DUP == 31 || PROBE_HOST_DUP == 32)) { Args b = a; b.ph_lo = 3; b.ph_hi = 4; b.li = PROBE_HOST_DUP - 30; hipLaunchKernelGGL(mega, dim3(grid), dim3(NTHR), LDS_BYTES, stream, b); } }
}
```

```cpp
#include <hip/hip_runtime.h>
#include <cstdio>
#include <cstdint>

#define LAS __attribute__((address_space(3)))
#define GAS __attribute__((address_space(1)))
typedef unsigned short bf16;
typedef unsigned v4u __attribute__((ext_vector_type(4)));
typedef unsigned v2u __attribute__((ext_vector_type(2)));
typedef float f32x4 __attribute__((ext_vector_type(4)));
typedef short bf16x8 __attribute__((ext_vector_type(8)));

constexpr int NB = 32, SEQ = 2048, DM = 1024, MTOK = NB * SEQ;
constexpr int NPROJ = 1280, FW = 512, KOUT = 1024;
constexpr int NEXP = 16, CAP = 256, DEXP = 1024, NPAIR = NB * NEXP, NSLOT = NPAIR * CAP;
constexpr int NADA = 6 * DM;
constexpr float EPS = 1e-6f;
constexpr float LOG2E = 1.4426950408889634f;

constexpr size_t MiB = 1u << 20;
constexpr size_t WS_CTL = 0, CTL_BYTES = 1 * MiB;
constexpr size_t WS_MOD = 1 * MiB;
constexpr size_t WS_MAT = 1 * MiB + 896 * 1024;
constexpr size_t WS_MBT = 1 * MiB + 960 * 1024;
constexpr size_t WS_WIN = 2 * MiB;
constexpr size_t WS_WOUT = 5 * MiB;
constexpr size_t WS_T = 8 * MiB;
constexpr size_t WS_WGU = 16 * MiB;
constexpr size_t WS_WD = 80 * MiB;
constexpr size_t WS_AFF = 112 * MiB;
constexpr size_t WS_IDX = 116 * MiB;
constexpr size_t WS_GATE = 116 * MiB + 512 * 1024;
constexpr size_t WS_INV = 117 * MiB;
constexpr size_t WS_K = 122 * MiB;
constexpr size_t WS_V = 138 * MiB;
constexpr size_t WS_H = 160 * MiB;
constexpr size_t WS_ET = 288 * MiB;
constexpr size_t WS_OT = 320 * MiB;
constexpr size_t WS_U1024 = 1 * MiB + 832 * 1024;
constexpr size_t WS_Q = 352 * MiB;
constexpr size_t WS_YB = 160 * MiB;
constexpr size_t WS_Y = 416 * MiB;
constexpr size_t WS_PA = 544 * MiB;
constexpr size_t WS_H2 = 416 * MiB;
constexpr size_t WS_ACT = 608 * MiB;
constexpr size_t WS_DELTA = 864 * MiB;
constexpr size_t WS_END = 992 * MiB;

typedef __bf16 bf16x2_t __attribute__((ext_vector_type(2)));
__device__ __forceinline__ unsigned f2bf(float f) { return (unsigned)__builtin_bit_cast(unsigned short, (__bf16)f); }
__device__ __forceinline__ unsigned pk2(float lo, float hi) { bf16x2_t v; v.x = (__bf16)lo; v.y = (__bf16)hi; return __builtin_bit_cast(unsigned, v); }
__device__ __forceinline__ unsigned pk4_fp8(float a, float b, float c, float d) { int w = 0; w = __builtin_amdgcn_cvt_pk_fp8_f32(a, b, w, false); w = __builtin_amdgcn_cvt_pk_fp8_f32(c, d, w, true); return (unsigned)w; }
constexpr float W8S = 32.f, W8I = 1.f / 32.f;
__device__ __forceinline__ float bf2f(unsigned b) { return __builtin_bit_cast(float, b << 16); }
__device__ __forceinline__ float wave_sum(float v) {
#pragma unroll
    for (int o = 1; o < 64; o <<= 1) v += __shfl_xor(v, o);
    return v;
}
__device__ __forceinline__ float wave_max(float v) {
#pragma unroll
    for (int o = 1; o < 64; o <<= 1) v = fmaxf(v, __shfl_xor(v, o));
    return v;
}
__device__ __forceinline__ int lane_fresh() { int l; asm volatile("v_mbcnt_lo_u32_b32 %0, -1, 0\n\tv_mbcnt_hi_u32_b32 %0, -1, %0" : "=v"(l)); return l; }
__device__ __forceinline__ int t5_bucket(int rel) {
    const int ret = rel > 0 ? 16 : 0; const int n = rel < 0 ? -rel : rel;
    if (n < 8) return ret + n;
    int lg = 31 - __builtin_clz((unsigned)(n * n)) - 6;
    lg = lg > 7 ? 7 : lg;
    return ret + 8 + lg;
}

struct Args {
    const float* in[18]; float* out; unsigned char* ws; int ph_lo, ph_hi, li, pad;
};
typedef const __attribute__((address_space(4))) Args* KArgs;
__device__ __forceinline__ KArgs kargs() { KArgs p = (KArgs)__builtin_amdgcn_kernarg_segment_ptr(); asm volatile("" : "+s"(p)); return p; }
enum { I_X = 0, I_C, I_RELB, I_WADA, I_BADA, I_NMG, I_NFG, I_WIN, I_WF, I_BF, I_QG, I_KG, I_SINK, I_WOUT, I_WR, I_WG, I_WU, I_WD };

constexpr int NWAVES = 8, NTHR = 512;
constexpr int LDS_BYTES = 155648;

__device__ __forceinline__ void p0_fill_cs(const float* c, LAS float* cs, int tid) {
    for (int it = 0; it < 16; ++it) { const int k = it * 64 + (tid >> 3), b4 = tid & 7; f32x4 v;
#pragma unroll
        for (int j = 0; j < 4; ++j) { const float x = c[(4 * b4 + j) * DM + k]; v[j] = x / (1.f + expf(-x)); }
        *(LAS f32x4*)(cs + k * 32 + 4 * b4) = v; }
}
__device__ __forceinline__ void p0_mod(KArgs a, LAS unsigned char* lds, int tid, int G) {
    LAS float* cs = (LAS float*)lds;
    const float* c = a->in[I_C];
    p0_fill_cs(c, cs, tid);
    __syncthreads();
    float* MOD = (float*)(a->ws + WS_MOD);
    const float* w_ada = a->in[I_WADA]; const float* b_ada = a->in[I_BADA];
    const int wave = tid >> 6, lane = tid & 63, kk = lane >> 5, j = lane & 31;
    for (int it = blockIdx.x; it < 256; it += G) {
        const int col0 = it * 24;
        float acc[32];
#pragma unroll
        for (int b = 0; b < 32; ++b) acc[b] = 0.f;
        if (j < 24) {
#pragma unroll 1
            for (int hf = 0; hf < 4; ++hf) {
                float w[16];
#pragma unroll
                for (int i = 0; i < 16; ++i) w[i] = w_ada[(size_t)(wave * 128 + 2 * (hf * 16 + i) + kk) * NADA + col0 + j];
#pragma unroll
                for (int i = 0; i < 16; ++i) { const int k = wave * 128 + 2 * (hf * 16 + i) + kk;
#pragma unroll
                    for (int b4 = 0; b4 < 8; ++b4) { const f32x4 cv = *(const LAS f32x4*)(cs + k * 32 + 4 * b4); acc[4 * b4] += cv.x * w[i]; acc[4 * b4 + 1] += cv.y * w[i]; acc[4 * b4 + 2] += cv.z * w[i]; acc[4 * b4 + 3] += cv.w * w[i]; }
                    asm volatile("" ::: "memory"); }
            }
        }
        __syncthreads();
        LAS float* part = (LAS float*)lds;
        if (j < 24) {
#pragma unroll
            for (int b = 0; b < 32; ++b) part[((wave * 2 + kk) * 32 + b) * 24 + j] = acc[b]; }
        __syncthreads();
        for (int o = tid; o < 768; o += NTHR) { const int bb = o / 24, jj = o % 24; float s = b_ada[col0 + jj];
            for (int p = 0; p < 16; ++p) s += part[(p * 32 + bb) * 24 + jj];
            MOD[bb * NADA + col0 + jj] = s; }
        __syncthreads();
        if (it + G < 256) { p0_fill_cs(c, cs, tid); __syncthreads(); }
    }
}
__device__ __forceinline__ void p0_transpose_item(const float* W, int N, bf16* WT, int ldk, int koff, int drow0, int hi_off, LAS float* scr, int k0, int n0, int lane) {
    f32x4 v[16];
#pragma unroll
    for (int i = 0; i < 16; ++i) v[i] = __builtin_nontemporal_load((const f32x4*)(W + (size_t)(k0 + 4 * i + (lane >> 4)) * N + n0 + 4 * (lane & 15)));
#pragma unroll
    for (int i = 0; i < 16; ++i) { const int kk = 4 * i + (lane >> 4); *(LAS f32x4*)(scr + kk * 64 + 4 * ((lane & 15) ^ (kk >> 3))) = v[i]; }
    asm volatile("s_waitcnt lgkmcnt(0)" ::: "memory");
    const int c = lane & 7;
#pragma unroll
    for (int j = 0; j < 8; ++j) { const int n = (lane >> 3) + 8 * j; float e[8];
#pragma unroll
        for (int t = 0; t < 8; ++t) e[t] = scr[(8 * c + t) * 64 + 4 * ((n >> 2) ^ c) + (n & 3)];
        v4u o; o.x = pk2(e[0], e[1]); o.y = pk2(e[2], e[3]); o.z = pk2(e[4], e[5]); o.w = pk2(e[6], e[7]);
        *(v4u*)(WT + (size_t)(drow0 + (n & 31) + hi_off * (n >> 5)) * ldk + koff + k0 + 8 * c) = o; }
    asm volatile("s_waitcnt lgkmcnt(0)" ::: "memory");
}
__device__ __forceinline__ void p0_transpose_item_fp8(const float* W, int N, unsigned char* WT, int drow0, LAS float* scr, int k0, int n0, int lane) {
    f32x4 v[16];
#pragma unroll
    for (int i = 0; i < 16; ++i) v[i] = __builtin_nontemporal_load((const f32x4*)(W + (size_t)(k0 + 4 * i + (lane >> 4)) * N + n0 + 4 * (lane & 15)));
#pragma unroll
    for (int i = 0; i < 16; ++i) { const int kk = 4 * i + (lane >> 4); *(LAS f32x4*)(scr + kk * 64 + 4 * ((lane & 15) ^ (kk >> 3))) = v[i]; }
    asm volatile("s_waitcnt lgkmcnt(0)" ::: "memory");
    const int n = lane;
#pragma unroll
    for (int c = 0; c < 8; c += 2) { float e[16];
#pragma unroll
        for (int t = 0; t < 16; ++t) { const int k = 8 * c + t; e[t] = scr[k * 64 + 4 * ((n >> 2) ^ (k >> 3)) + (n & 3)] * W8S; }
        v4u o; o.x = pk4_fp8(e[0], e[1], e[2], e[3]); o.y = pk4_fp8(e[4], e[5], e[6], e[7]); o.z = pk4_fp8(e[8], e[9], e[10], e[11]); o.w = pk4_fp8(e[12], e[13], e[14], e[15]);
        *(v4u*)(WT + (size_t)(drow0 + n) * 1024 + k0 + 8 * c) = o; }
    asm volatile("s_waitcnt lgkmcnt(0)" ::: "memory");
}
__device__ __forceinline__ void p0_maps(KArgs a, LAS unsigned char* lds, int tid, int G) {
    LAS float* wf = (LAS float*)lds;
    LAS float* ct = wf + 4096;
    LAS float* st = ct + 64;
    bf16* MAT = (bf16*)(a->ws + WS_MAT); bf16* MBT = (bf16*)(a->ws + WS_MBT);
    const float* w_f = a->in[I_WF];
    const float scale = 0.0027621358640099515f;
    for (int g = blockIdx.x; g < 8; g += G) {
        for (int i = tid; i < 4096; i += NTHR) wf[i] = w_f[g * 4096 + i];
        if (tid < 64) { ct[tid] = cospif((float)tid / 32.f); st[tid] = sinpif((float)tid / 32.f); }
        __syncthreads();
        for (int o = tid; o < 4096; o += NTHR) { const int d = o >> 6, c = o & 63; float sc = 0.f, ss = 0.f;
            for (int m = 0; m < 64; ++m) { const float w = wf[m * 64 + d]; const int ph = (m * c) & 63; sc += ct[ph] * w; ss += st[ph] * w; }
            MAT[g * 4096 + o] = (bf16)f2bf(sc * scale); MBT[g * 4096 + o] = (bf16)f2bf(-ss * scale); }
        __syncthreads();
    }
}
__device__ __forceinline__ void p0_rest(KArgs a, LAS unsigned char* lds, int tid, int wave, int lane, int vcu, int G) {
    LAS float* scr = (LAS float*)(lds + wave * 16384);
    const int gw = vcu * NWAVES + wave, NGW = G * NWAVES;
    bf16* WIN_T = (bf16*)(a->ws + WS_WIN); bf16* WOUT_T = (bf16*)(a->ws + WS_WOUT); unsigned char* WGU = a->ws + WS_WGU; unsigned char* WD = a->ws + WS_WD;
    constexpr int I_A = 16 * 20, I_B = 16 * 16, I_E = 16 * 16;
    constexpr int NITEMS = I_A + I_B + 16 * 3 * I_E;
    for (int it = gw; it < NITEMS; it += NGW) {
        int r = it;
        if (r < I_A) { const int kb = r / 20, nb = r % 20, n0 = nb * 64;
            const int t = n0 >> 8, hh = (n0 & 255) >> 6, drow = 256 * t + 32 * hh, hi = 128;
            p0_transpose_item(a->in[I_WIN], NPROJ, WIN_T, DM, 0, drow, hi, scr, kb * 64, n0, lane); continue; }
        r -= I_A;
        if (r < I_B) { const int kb = r / 16, nb = r % 16; p0_transpose_item(a->in[I_WOUT], DM, WOUT_T, KOUT, 0, nb * 64, 32, scr, kb * 64, nb * 64, lane); continue; }
        r -= I_B;
        const int e = r / (3 * I_E), r2 = r % (3 * I_E), which = r2 / I_E, r3 = r2 % I_E, kb = r3 / 16, nb = r3 % 16, n0 = nb * 64;
        if (which == 0) p0_transpose_item_fp8(a->in[I_WG] + (size_t)e * DM * DEXP, DEXP, WGU + (size_t)e * 2048 * 1024, 256 * (n0 >> 7) + (n0 & 127), scr, kb * 64, n0, lane);
        else if (which == 1) p0_transpose_item_fp8(a->in[I_WU] + (size_t)e * DM * DEXP, DEXP, WGU + (size_t)e * 2048 * 1024, 256 * (n0 >> 7) + 128 + (n0 & 127), scr, kb * 64, n0, lane);
        else p0_transpose_item_fp8(a->in[I_WD] + (size_t)e * DEXP * DM, DM, WD + (size_t)e * 1024 * 1024, n0, scr, kb * 64, n0, lane);
    }
    bf16* T = (bf16*)(a->ws + WS_T);
    for (int r = gw; r < 2048; r += NGW) {
#pragma unroll
        for (int i2 = 0; i2 < 2; ++i2) { const int s0 = i2 * 512 + lane * 8; float v[8];
#pragma unroll
            for (int j = 0; j < 8; ++j) { const int sp = s0 + j;
                v[j] = (r < 1024) ? cospif((float)((r * sp) & 2047) / 1024.f) : sinpif((float)(((r - 1024) * sp) & 2047) / 1024.f); }
            v4u o; o.x = pk2(v[0], v[1]); o.y = pk2(v[2], v[3]); o.z = pk2(v[4], v[5]); o.w = pk2(v[6], v[7]);
            *(v4u*)(T + (size_t)r * 1024 + s0) = o; }
    }
}

__device__ __forceinline__ void ld_row_f32(const float* p, int lane, f32x4 (&v)[4]) {
    v[0] = __builtin_nontemporal_load((const f32x4*)(p + 8 * lane)); v[1] = __builtin_nontemporal_load((const f32x4*)(p + 8 * lane + 4)); v[2] = __builtin_nontemporal_load((const f32x4*)(p + 512 + 8 * lane)); v[3] = __builtin_nontemporal_load((const f32x4*)(p + 512 + 8 * lane + 4)); }
__device__ __forceinline__ void ld_row_f32c(const float* p, int lane, f32x4 (&v)[4]) {
    v[0] = *(const f32x4*)(p + 8 * lane); v[1] = *(const f32x4*)(p + 8 * lane + 4); v[2] = *(const f32x4*)(p + 512 + 8 * lane); v[3] = *(const f32x4*)(p + 512 + 8 * lane + 4); }
__device__ __forceinline__ void ld_row_bf(const bf16* p, int lane, v4u (&d)[2]) { d[0] = __builtin_nontemporal_load((const v4u*)(p + 8 * lane)); d[1] = __builtin_nontemporal_load((const v4u*)(p + 512 + 8 * lane)); }
__device__ __forceinline__ void add_bf(f32x4 (&v)[4], const v4u (&d)[2]) {
#pragma unroll
    for (int h = 0; h < 2; ++h) { v[2 * h].x += bf2f(d[h].x & 0xffffu); v[2 * h].y += bf2f(d[h].x >> 16); v[2 * h].z += bf2f(d[h].y & 0xffffu); v[2 * h].w += bf2f(d[h].y >> 16);
        v[2 * h + 1].x += bf2f(d[h].z & 0xffffu); v[2 * h + 1].y += bf2f(d[h].z >> 16); v[2 * h + 1].z += bf2f(d[h].w & 0xffffu); v[2 * h + 1].w += bf2f(d[h].w >> 16); } }
__device__ __forceinline__ void st_row_bf(bf16* p, int lane, const f32x4 (&v)[4]) {
#pragma unroll
    for (int h = 0; h < 2; ++h) { v4u w; w.x = pk2(v[2 * h].x, v[2 * h].y); w.y = pk2(v[2 * h].z, v[2 * h].w); w.z = pk2(v[2 * h + 1].x, v[2 * h + 1].y); w.w = pk2(v[2 * h + 1].z, v[2 * h + 1].w); __builtin_nontemporal_store(w, (v4u*)(p + 512 * h + 8 * lane)); } }
__device__ __forceinline__ void st_row_bf_plain(bf16* p, int lane, const f32x4 (&v)[4]) {
#pragma unroll
    for (int h = 0; h < 2; ++h) { v4u w; w.x = pk2(v[2 * h].x, v[2 * h].y); w.y = pk2(v[2 * h].z, v[2 * h].w); w.z = pk2(v[2 * h + 1].x, v[2 * h + 1].y); w.w = pk2(v[2 * h + 1].z, v[2 * h + 1].w); *(v4u*)(p + 512 * h + 8 * lane) = w; } }
__device__ __forceinline__ void ld_row_fp8(const unsigned char* p, int lane, v2u (&d)[2]) { d[0] = __builtin_nontemporal_load((const v2u*)(p + 8 * lane)); d[1] = __builtin_nontemporal_load((const v2u*)(p + 512 + 8 * lane)); }
__device__ __forceinline__ void add_fp8(f32x4 (&v)[4], const v2u (&d)[2]) {
    typedef float f2 __attribute__((ext_vector_type(2)));
#pragma unroll
    for (int h = 0; h < 2; ++h) { const f2 a = __builtin_amdgcn_cvt_pk_f32_fp8((int)d[h].x, false), b = __builtin_amdgcn_cvt_pk_f32_fp8((int)d[h].x, true), c = __builtin_amdgcn_cvt_pk_f32_fp8((int)d[h].y, false), e = __builtin_amdgcn_cvt_pk_f32_fp8((int)d[h].y, true);
        v[2 * h].x += a.x; v[2 * h].y += a.y; v[2 * h].z += b.x; v[2 * h].w += b.y; v[2 * h + 1].x += c.x; v[2 * h + 1].y += c.y; v[2 * h + 1].z += e.x; v[2 * h + 1].w += e.y; } }
__device__ __forceinline__ void st_row_fp8(unsigned char* p, int lane, const f32x4 (&v)[4]) {
#pragma unroll
    for (int h = 0; h < 2; ++h) { v2u w; w.x = pk4_fp8(v[2 * h].x, v[2 * h].y, v[2 * h].z, v[2 * h].w); w.y = pk4_fp8(v[2 * h + 1].x, v[2 * h + 1].y, v[2 * h + 1].z, v[2 * h + 1].w); *(v2u*)(p + 512 * h + 8 * lane) = w; } }
__device__ __forceinline__ float ssq4(const f32x4 (&v)[4]) { float s = 0.f;
#pragma unroll
    for (int j = 0; j < 4; ++j) s += (v[j].x * v[j].x + v[j].y * v[j].y) + (v[j].z * v[j].z + v[j].w * v[j].w);
    return s; }

__device__ __forceinline__ size_t h_row(int tok) { const int b = tok >> 11, s_ = tok & 2047; int t, r;
    if (s_ < 1024) { t = s_ >> 7; r = s_ & 127; } else if (s_ == 1024) { t = 0; r = 128; } else { const int sp = SEQ - s_; t = sp >> 7; r = 128 + (sp & 127); }
    return (size_t)(b * 8 + t) * 256 + r; }
__device__ __forceinline__ void p1_pair(const f32x4 (&va)[4], const f32x4 (&vb)[4], const f32x4 (&gs)[4], const f32x4 (&sh)[4], bf16* ha, bf16* hb, int lane) {
    float s0 = ssq4(va), s1 = ssq4(vb);
#pragma unroll
    for (int o = 1; o < 64; o <<= 1) { s0 += __shfl_xor(s0, o); s1 += __shfl_xor(s1, o); }
    const float r0 = 1.f / sqrtf(s0 * (1.f / DM) + EPS), r1 = 1.f / sqrtf(s1 * (1.f / DM) + EPS);
    f32x4 o[4];
#pragma unroll
    for (int j = 0; j < 4; ++j) o[j] = va[j] * r0 * gs[j] + sh[j];
    st_row_bf_plain(ha, lane, o);
#pragma unroll
    for (int j = 0; j < 4; ++j) o[j] = vb[j] * r1 * gs[j] + sh[j];
    st_row_bf_plain(hb, lane, o);
}
__device__ __forceinline__ void p1_h(KArgs a, int wave, int lane, int vcu, int G) {
    const int gw = vcu * NWAVES + wave, NGW = G * NWAVES;
    const float* MOD = (const float*)(a->ws + WS_MOD); const float* g = a->in[I_NMG]; const float* x = a->in[I_X]; bf16* H = (bf16*)(a->ws + WS_H);
    f32x4 gg[4]; ld_row_f32c(g, lane, gg);
    const int nst = MTOK / 4 / NGW;
    f32x4 a0[4], a1[4], b0[4], b1[4];
    { const float* xr = x + (size_t)(4 * gw) * DM; ld_row_f32(xr, lane, a0); ld_row_f32(xr + DM, lane, a1); }
    for (int it = 0; it < nst; ++it) {
        const int row0 = 4 * (it * NGW + gw), b = row0 / SEQ;
        const float* xr = x + (size_t)row0 * DM;
        ld_row_f32(xr + 2 * DM, lane, b0); ld_row_f32(xr + 3 * DM, lane, b1);
        f32x4 gs[4], sh[4];
        { f32x4 sc[4]; ld_row_f32c(MOD + b * NADA + DM, lane, sc); ld_row_f32c(MOD + b * NADA, lane, sh);
#pragma unroll
          for (int j = 0; j < 4; ++j) gs[j] = gg[j] * (sc[j] + 1.f); }
        p1_pair(a0, a1, gs, sh, H + h_row(row0) * DM, H + h_row(row0 + 1) * DM, lane);
        if (it + 1 < nst) { const float* xn = x + (size_t)(4 * ((it + 1) * NGW + gw)) * DM; ld_row_f32(xn, lane, a0); ld_row_f32(xn + DM, lane, a1); }
        p1_pair(b0, b1, gs, sh, H + h_row(row0 + 2) * DM, H + h_row(row0 + 3) * DM, lane);
    }
}

__device__ __forceinline__ float bfly16(const float (&t)[16], int lane) {
    const bool b5 = lane & 32, b4 = lane & 16, b3 = lane & 8, b2 = lane & 4;
    float u8[8], u4[4], u2[2], u1;
#pragma unroll
    for (int i = 0; i < 8; ++i) { const float send = b5 ? t[i] : t[i + 8], keep = b5 ? t[i + 8] : t[i]; u8[i] = keep + __shfl_xor(send, 32); }
#pragma unroll
    for (int i = 0; i < 4; ++i) { const float send = b4 ? u8[i] : u8[i + 4], keep = b4 ? u8[i + 4] : u8[i]; u4[i] = keep + __shfl_xor(send, 16); }
#pragma unroll
    for (int i = 0; i < 2; ++i) { const float send = b3 ? u4[i] : u4[i + 2], keep = b3 ? u4[i + 2] : u4[i]; u2[i] = keep + __shfl_xor(send, 8); }
    { const float send = b2 ? u2[0] : u2[1], keep = b2 ? u2[1] : u2[0]; u1 = keep + __shfl_xor(send, 4); }
    u1 += __shfl_xor(u1, 2); u1 += __shfl_xor(u1, 1);
    return u1;
}
__device__ __forceinline__ void dot16(const f32x4 (&v)[4], const LAS float* wr, int lane, float (&t)[16]) {
#pragma unroll
    for (int e = 0; e < 16; ++e) { float t0 = 0.f;
#pragma unroll
        for (int j = 0; j < 4; ++j) { const f32x4 w4 = *(const LAS f32x4*)(wr + e * 1024 + 256 * j + 4 * lane); t0 += (v[j].x * w4.x + v[j].y * w4.y) + (v[j].z * w4.z + v[j].w * w4.w); }
        t[e] = t0; asm volatile("" ::: "memory"); }
}
__device__ __forceinline__ void dot16x2(const f32x4 (&v0)[4], const f32x4 (&v1)[4], const LAS float* wr, int lane, float (&t0)[16], float (&t1)[16]) {
#pragma unroll
    for (int e = 0; e < 16; ++e) { f32x4 a0 = {0.f, 0.f, 0.f, 0.f}, a1 = a0;
#pragma unroll
        for (int j = 0; j < 4; ++j) { const f32x4 w4 = *(const LAS f32x4*)(wr + e * 1024 + 256 * j + 4 * lane); a0 += v0[j] * w4; a1 += v1[j] * w4; }
        t0[e] = (a0.x + a0.y) + (a0.z + a0.w); t1[e] = (a1.x + a1.y) + (a1.z + a1.w); asm volatile("" ::: "memory"); }
}
__device__ __forceinline__ void p5_router(KArgs a, LAS unsigned char* lds, int tid, int wave, int lane, int vcu, int G) {
    LAS float* wr = (LAS float*)lds;
    const float* w_router = a->in[I_WR];
    for (int i = tid; i < DM * NEXP; i += NTHR) { const int k = i >> 4, e = i & 15;
        wr[e * 1024 + 256 * (2 * (k >> 9) + ((k >> 2) & 1)) + 4 * ((k >> 3) & 63) + (k & 3)] = w_router[i]; }
    __syncthreads();
    const int gw = vcu * NWAVES + wave, NGW = G * NWAVES;
    const float* MOD = (const float*)(a->ws + WS_MOD); const float* g = a->in[I_NFG]; const float* x = a->in[I_X]; const bf16* DELTA = (const bf16*)(a->ws + WS_DELTA);
    unsigned char* H2 = a->ws + WS_H2; float* AFF = (float*)(a->ws + WS_AFF);
    for (int blk = gw; blk < MTOK / 32; blk += NGW) {
        const int row0 = blk * 32, b = row0 / SEQ;
        f32x4 gs[4], sh[4]; float ce;
        { f32x4 gg[4], sc[4]; ld_row_f32c(g, lane, gg); ld_row_f32c(MOD + b * NADA + 4 * DM, lane, sc); ld_row_f32c(MOD + b * NADA + 3 * DM, lane, sh);
#pragma unroll
          for (int j = 0; j < 4; ++j) gs[j] = gg[j] * (sc[j] + 1.f);
          float t[16]; dot16(sh, wr, lane, t); ce = bfly16(t, lane); }
        const float* xr = x + (size_t)row0 * DM; const bf16* dr = DELTA + (size_t)row0 * DM;
        f32x4 vn0[4], vn1[4]; v4u dn0[2], dn1[2];
        ld_row_f32(xr, lane, vn0); ld_row_bf(dr, lane, dn0); ld_row_f32(xr + DM, lane, vn1); ld_row_bf(dr + DM, lane, dn1);
        for (int r = 0; r < 32; r += 2) {
            f32x4 v0[4], v1[4];
#pragma unroll
            for (int j = 0; j < 4; ++j) { v0[j] = vn0[j]; v1[j] = vn1[j]; }
            add_bf(v0, dn0); add_bf(v1, dn1);
            if (r + 2 < 32) { ld_row_f32(xr + (size_t)(r + 2) * DM, lane, vn0); ld_row_bf(dr + (size_t)(r + 2) * DM, lane, dn0); ld_row_f32(xr + (size_t)(r + 3) * DM, lane, vn1); ld_row_bf(dr + (size_t)(r + 3) * DM, lane, dn1); }
            float s0 = ssq4(v0), s1 = ssq4(v1);
#pragma unroll
            for (int j = 0; j < 4; ++j) { v0[j] = v0[j] * gs[j]; v1[j] = v1[j] * gs[j]; }
            float t0[16], t1[16]; dot16x2(v0, v1, wr, lane, t0, t1);
            float lg0 = bfly16(t0, lane), lg1 = bfly16(t1, lane);
#pragma unroll
            for (int o = 1; o < 64; o <<= 1) { s0 += __shfl_xor(s0, o); s1 += __shfl_xor(s1, o); }
            const float rs0 = 1.f / sqrtf(s0 * (1.f / DM) + EPS), rs1 = 1.f / sqrtf(s1 * (1.f / DM) + EPS);
#pragma unroll
            for (int j = 0; j < 4; ++j) { v0[j] = v0[j] * rs0 + sh[j]; v1[j] = v1[j] * rs1 + sh[j]; }
            st_row_fp8(H2 + (size_t)(row0 + r) * DM, lane, v0); st_row_fp8(H2 + (size_t)(row0 + r + 1) * DM, lane, v1);
            lg0 = lg0 * rs0 + ce; lg1 = lg1 * rs1 + ce;
            float mx0 = lg0, mx1 = lg1;
#pragma unroll
            for (int o = 4; o < 64; o <<= 1) { mx0 = fmaxf(mx0, __shfl_xor(mx0, o)); mx1 = fmaxf(mx1, __shfl_xor(mx1, o)); }
            const float p0 = expf(lg0 - mx0), p1 = expf(lg1 - mx1); float sum0 = p0, sum1 = p1;
#pragma unroll
            for (int o = 4; o < 64; o <<= 1) { sum0 += __shfl_xor(sum0, o); sum1 += __shfl_xor(sum1, o); }
            if ((lane & 3) == 0) { float* ap = AFF + ((size_t)b * NEXP + ((lane >> 2) & 15)) * SEQ + (row0 + r - b * SEQ); ap[0] = p0 / sum0; ap[1] = p1 / sum1; }
        }
    }
    __syncthreads();
}

__device__ __forceinline__ void p6_topk(KArgs a, LAS unsigned char* lds, int tid, int G) {
    LAS unsigned* hist = (LAS unsigned*)lds;
    LAS unsigned* sel = hist + 256;
    LAS unsigned* wtot = hist + 264;
    const float* AFF = (const float*)(a->ws + WS_AFF); int* IDX = (int*)(a->ws + WS_IDX); float* GATE = (float*)(a->ws + WS_GATE); int* INV = (int*)(a->ws + WS_INV);
    const int lane = tid & 63, wave = tid >> 6;
    for (int it = blockIdx.x; it < NPAIR; it += G) {
        const int b = it >> 4, e = it & 15;
        const v4u kv = *(const v4u*)(AFF + (size_t)it * SEQ + 4 * tid);
        const unsigned key[4] = {kv.x, kv.y, kv.z, kv.w};
        unsigned prefix = 0u, mask = 0u, krem = CAP;
#pragma unroll 1
        for (int shift = 24; shift >= 0; shift -= 8) {
            if (tid < 256) hist[tid] = 0u;
            __syncthreads();
#pragma unroll
            for (int i = 0; i < 4; ++i) if ((key[i] & mask) == prefix) __hip_atomic_fetch_add(hist + ((key[i] >> shift) & 255u), 1u, __ATOMIC_RELAXED, __HIP_MEMORY_SCOPE_WORKGROUP);
            __syncthreads();
            if (wave == 0) {
                const unsigned h0 = hist[4 * lane], h1 = hist[4 * lane + 1], h2 = hist[4 * lane + 2], h3 = hist[4 * lane + 3];
                const unsigned tot = h0 + h1 + h2 + h3; unsigned inc = tot;
#pragma unroll
                for (int o = 1; o < 64; o <<= 1) { const unsigned t = __shfl_down(inc, o); if (lane + o < 64) inc += t; }
                const unsigned above3 = inc - tot, above2 = above3 + h3, above1 = above2 + h2, above0 = above1 + h1;
                if (above3 < krem && krem <= above3 + h3) { sel[0] = 4 * lane + 3; sel[1] = krem - above3; }
                if (above2 < krem && krem <= above2 + h2) { sel[0] = 4 * lane + 2; sel[1] = krem - above2; }
                if (above1 < krem && krem <= above1 + h1) { sel[0] = 4 * lane + 1; sel[1] = krem - above1; }
                if (above0 < krem && krem <= above0 + h0) { sel[0] = 4 * lane;     sel[1] = krem - above0; }
            }
            __syncthreads();
            prefix |= sel[0] << shift; mask |= 255u << shift; krem = sel[1];
        }
        unsigned cg = 0, ce = 0;
#pragma unroll
        for (int i = 0; i < 4; ++i) { cg += key[i] > prefix; ce += key[i] == prefix; }
        unsigned pk = cg | (ce << 16), inc = pk;
#pragma unroll
        for (int o = 1; o < 64; o <<= 1) { const unsigned t = __shfl_up(inc, o); if (lane >= o) inc += t; }
        if (lane == 63) wtot[wave] = inc;
        __syncthreads();
        unsigned base = 0;
        for (int w = 0; w < wave; ++w) base += wtot[w];
        unsigned excl = base + inc - pk; unsigned ng = excl & 0xffffu, ne = excl >> 16;
#pragma unroll
        for (int i = 0; i < 4; ++i) { const int s_ = 4 * tid + i; int slot = -1;
            if (key[i] > prefix) { slot = (int)(ng + (ne < krem ? ne : krem)); ++ng; }
            else if (key[i] == prefix) { if (ne < krem) slot = (int)(ng + ne); ++ne; }
            if (slot >= 0) { IDX[it * CAP + slot] = s_; GATE[it * CAP + slot] = __builtin_bit_cast(float, key[i]); }
            INV[((size_t)b * SEQ + s_) * NEXP + e] = slot; }
        __syncthreads();
    }
}

__device__ __forceinline__ void p9_rows2(const f32x4 (&xa)[4], const v4u (&da)[2], const f32x4 (&xb)[4], const v4u (&db)[2], int inv, int q0, const unsigned char* YBb, const f32x4 (&g2)[4], float* oa, float* ob, int lane) {
    f32x4 acc0[4], acc1[4];
#pragma unroll
    for (int j = 0; j < 4; ++j) { acc0[j] = (f32x4){0.f, 0.f, 0.f, 0.f}; acc1[j] = (f32x4){0.f, 0.f, 0.f, 0.f}; }
    const unsigned long long bal = __ballot(inv >= 0);
    unsigned m0 = (unsigned)(bal >> (16 * q0)) & 0xffffu, m1 = (unsigned)(bal >> (16 * q0 + 16)) & 0xffffu;
    while (m0 | m1) {
        int ea0 = -1, ea1 = -1, eb0 = -1, eb1 = -1;
        if (m0) { ea0 = __builtin_ctz(m0); m0 &= m0 - 1; } if (m0) { ea1 = __builtin_ctz(m0); m0 &= m0 - 1; }
        if (m1) { eb0 = __builtin_ctz(m1); m1 &= m1 - 1; } if (m1) { eb1 = __builtin_ctz(m1); m1 &= m1 - 1; }
        v2u ya0[2], ya1[2], yb0[2], yb1[2];
        if (ea0 >= 0) { const int c = __builtin_amdgcn_readlane(inv, q0 * 16 + ea0); ld_row_fp8(YBb + ((size_t)ea0 * CAP + c) * DM, lane, ya0); }
        if (ea1 >= 0) { const int c = __builtin_amdgcn_readlane(inv, q0 * 16 + ea1); ld_row_fp8(YBb + ((size_t)ea1 * CAP + c) * DM, lane, ya1); }
        if (eb0 >= 0) { const int c = __builtin_amdgcn_readlane(inv, q0 * 16 + 16 + eb0); ld_row_fp8(YBb + ((size_t)eb0 * CAP + c) * DM, lane, yb0); }
        if (eb1 >= 0) { const int c = __builtin_amdgcn_readlane(inv, q0 * 16 + 16 + eb1); ld_row_fp8(YBb + ((size_t)eb1 * CAP + c) * DM, lane, yb1); }
        if (ea0 >= 0) add_fp8(acc0, ya0); if (ea1 >= 0) add_fp8(acc0, ya1);
        if (eb0 >= 0) add_fp8(acc1, yb0); if (eb1 >= 0) add_fp8(acc1, yb1);
    }
    f32x4 o[4];
#pragma unroll
    for (int j = 0; j < 4; ++j) o[j] = xa[j];
    add_bf(o, da);
#pragma unroll
    for (int j = 0; j < 4; ++j) { o[j] = o[j] + g2[j] * acc0[j]; __builtin_nontemporal_store(o[j], (f32x4*)(oa + 512 * (j >> 1) + 8 * lane + 4 * (j & 1))); }
#pragma unroll
    for (int j = 0; j < 4; ++j) o[j] = xb[j];
    add_bf(o, db);
#pragma unroll
    for (int j = 0; j < 4; ++j) { o[j] = o[j] + g2[j] * acc1[j]; __builtin_nontemporal_store(o[j], (f32x4*)(ob + 512 * (j >> 1) + 8 * lane + 4 * (j & 1))); }
}
__device__ __forceinline__ void p9_combine(KArgs a, int wave, int lane, int vcu, int G) {
    const int gw = vcu * NWAVES + wave, NGW = G * NWAVES;
    const float* MOD = (const float*)(a->ws + WS_MOD); const unsigned char* YB = a->ws + WS_YB;   const int* INV = (const int*)(a->ws + WS_INV); float* out = a->out;
    const float* x = a->in[I_X]; const bf16* DELTA = (const bf16*)(a->ws + WS_DELTA);
    for (int blk = gw; blk < MTOK / 32; blk += NGW) {
        const int row0 = blk * 32, b = row0 / SEQ;
        f32x4 g2[4]; ld_row_f32c(MOD + b * NADA + 5 * DM, lane, g2);
#pragma unroll
        for (int j = 0; j < 4; ++j) g2[j] = g2[j] * W8I;
        const unsigned char* YBb = YB + (size_t)b * NEXP * CAP * DM;
        const float* xr = x + (size_t)row0 * DM; const bf16* dr = DELTA + (size_t)row0 * DM; float* orow = out + (size_t)row0 * DM;
        f32x4 xa0[4], xa1[4], xb0[4], xb1[4]; v4u da0[2], da1[2], db0[2], db1[2];
        ld_row_f32(xr, lane, xa0); ld_row_bf(dr, lane, da0); ld_row_f32(xr + DM, lane, xa1); ld_row_bf(dr + DM, lane, da1);
        int inv = INV[(size_t)row0 * NEXP + lane];
        for (int r = 0; r < 32; r += 4) {
            ld_row_f32(xr + (size_t)(r + 2) * DM, lane, xb0); ld_row_bf(dr + (size_t)(r + 2) * DM, lane, db0); ld_row_f32(xr + (size_t)(r + 3) * DM, lane, xb1); ld_row_bf(dr + (size_t)(r + 3) * DM, lane, db1);
            const int invn = (r + 4 < 32) ? INV[(size_t)(row0 + r + 4) * NEXP + lane] : 0;
            p9_rows2(xa0, da0, xa1, da1, inv, 0, YBb, g2, orow + (size_t)r * DM, orow + (size_t)(r + 1) * DM, lane);
            if (r + 4 < 32) { ld_row_f32(xr + (size_t)(r + 4) * DM, lane, xa0); ld_row_bf(dr + (size_t)(r + 4) * DM, lane, da0); ld_row_f32(xr + (size_t)(r + 5) * DM, lane, xa1); ld_row_bf(dr + (size_t)(r + 5) * DM, lane, da1); }
            p9_rows2(xb0, db0, xb1, db1, inv, 2, YBb, g2, orow + (size_t)(r + 2) * DM, orow + (size_t)(r + 3) * DM, lane);
            inv = invn;
        }
    }
}

#define XB_TMO      128
#define XB_XCNT(j)  (256  + 64 * (j))
#define XB_XSUB(j)  (1280 + 64 * (j))
#define XB_XGEN(j)  (2304 + 64 * (j))
#define XB_TOP      3328
#define XB_TOPGEN   3392
#define XCD_BAR_WORDS 3456
#define XB_SPIN_CAP (1u << 22)
__device__ __forceinline__ unsigned xb_ld(unsigned* p)              { return __hip_atomic_load(p, __ATOMIC_RELAXED, __HIP_MEMORY_SCOPE_AGENT); }
__device__ __forceinline__ unsigned xb_add(unsigned* p, unsigned v) { return __hip_atomic_fetch_add(p, v, __ATOMIC_RELAXED, __HIP_MEMORY_SCOPE_AGENT); }
__device__ __forceinline__ unsigned xb_xcc_id() { return (unsigned)__builtin_amdgcn_s_getreg((3 << 11) | 20) & 0xFu; }
#define XB_SPIN(cond, bar) do { unsigned _sp = 0; while (cond) { __builtin_amdgcn_s_sleep(1); \
    if ((++_sp & 255u) == 0u) { if (xb_ld(&(bar)[XB_TMO])) break; if (_sp > XB_SPIN_CAP) { atomicAdd(&(bar)[XB_TMO], 1u); break; } } } } while (0)
struct XcdBarrier { unsigned* bar; unsigned x; volatile LAS unsigned* st; };
__device__ __forceinline__ XcdBarrier xcd_barrier_post(unsigned* bar, volatile LAS unsigned* st, int wave) {
    XcdBarrier b; b.bar = bar; b.x = xb_xcc_id(); b.st = st;
    if (wave == 0 && lane_fresh() == 0) (void)xb_add(&bar[XB_XCNT(b.x)], 1u);
    return b;
}
__device__ __forceinline__ void xcd_barrier_complete(unsigned* bar, unsigned x, unsigned& nloc, unsigned& nx) {
    const unsigned G = gridDim.x * gridDim.y * gridDim.z;
    unsigned sum, cnt, mine, sp = 0u;
    for (;;) {
        sum = 0u; cnt = 0u; mine = 0u;
#pragma unroll
        for (unsigned j = 0; j < 16; ++j) { const unsigned c = xb_ld(&bar[XB_XCNT(j)]); sum += c; cnt += (c > 0u) ? 1u : 0u; mine = (j == x) ? c : mine; }
        if (sum == G) break;
        __builtin_amdgcn_s_sleep(1);
        if ((++sp & 255u) == 0u) { if (xb_ld(&bar[XB_TMO])) break; if (sp > XB_SPIN_CAP) { atomicAdd(&bar[XB_TMO], 1u); break; } }
    }
    nloc = mine > 0u ? mine : 1u; nx = cnt > 0u ? cnt : 1u;
}
__device__ __forceinline__ void xcd_barrier(const XcdBarrier& b, int wave) {
    asm volatile("s_waitcnt vmcnt(0)" ::: "memory");
    __syncthreads();
    if (wave == 0 && lane_fresh() == 0) {
        unsigned* bar = b.bar;
        __builtin_amdgcn_s_waitcnt(0);
        unsigned nloc = b.st[0], nx = b.st[1];
        if (nloc == 0u) { xcd_barrier_complete(bar, b.x, nloc, nx); b.st[0] = nloc; b.st[1] = nx; }
        const unsigned old = xb_add(&bar[XB_XSUB(b.x)], 1u);
        const unsigned gen = old / nloc;
        if (old + 1u == (gen + 1u) * nloc) {
            __builtin_amdgcn_fence(__ATOMIC_RELEASE, "agent");
            asm volatile("s_waitcnt vmcnt(0)" ::: "memory");
            const unsigned og = xb_add(&bar[XB_TOP], 1u);
            const unsigned tg = og / nx;
            if (og + 1u == (tg + 1u) * nx) xb_add(&bar[XB_TOPGEN], 1u);
            else XB_SPIN(xb_ld(&bar[XB_TOPGEN]) == tg, bar);
            __builtin_amdgcn_fence(__ATOMIC_ACQUIRE, "agent");
            xb_add(&bar[XB_XGEN(b.x)], 1u);
            asm volatile("s_waitcnt vmcnt(0)" ::: "memory");
        } else {
            XB_SPIN(xb_ld(&bar[XB_XGEN(b.x)]) == gen, bar);
            __builtin_amdgcn_fence(__ATOMIC_ACQUIRE, "agent");
            asm volatile("s_waitcnt vmcnt(0)" ::: "memory");
        }
    }
    __syncthreads();
}

#ifndef PG8_ALIGN_EPI
#define PG8_ALIGN_EPI 1
#endif
namespace pg8 {
constexpr int BM = 256, BK = 64, HALF = 128, HTB = HALF * BK * 2, STAGE_BYTES = 8 * HTB, NXCD = 8, WGM = 8;
constexpr int UTAB_OFF = 147456 + 1024, MAXU = 24;
__host__ __device__ __forceinline__ int lds_byte(int r, int c) { const int st = (r >> 4) * 2 + (c >> 5), rr = r & 15, cc = c & 31, ob = rr * 64 + cc * 2; return st * 1024 + (ob ^ (((ob >> 9) & 1) << 5)); }
__host__ __device__ __forceinline__ void stage_rc(int b, int& R, int& C) { const int st = b / 1024, sb = b % 1024, swz = sb ^ (((sb >> 9) & 1) << 5); R = (st >> 1) * 16 + swz / 64; C = (st & 1) * 32 + (swz % 64) / 2; }
__host__ __device__ __forceinline__ int perm32(int rho) { const int n = rho >> 4, i = rho & 15; return 8 * (i >> 2) + 4 * n + (i & 3); }
typedef int v8i __attribute__((ext_vector_type(8))); typedef int v4i __attribute__((ext_vector_type(4)));
__device__ __forceinline__ v8i cat8(bf16x8 lo, bf16x8 hi) { return __builtin_shufflevector(__builtin_bit_cast(v4i, lo), __builtin_bit_cast(v4i, hi), 0, 1, 2, 3, 4, 5, 6, 7); }
struct Unit { int pm, pn; };
struct StaticOrder {
    int nM, nN, nwg, G, c;
    __device__ void init(int M, int N, int G_, int c_) { nM = M / BM; nN = N / BM; nwg = nM * nN; G = G_; c = c_; }
    __device__ bool next(int i, Unit& u) const {
        const long L = (long)i * G + c; if (L >= nwg) return false;
        int wgid = (int)L; { const int q = nwg / NXCD, r = nwg % NXCD, xcd = wgid % NXCD, off = wgid / NXCD; wgid = (xcd < r ? xcd * (q + 1) : r * (q + 1) + (xcd - r) * q) + off; }
        const int nig = WGM * nN, gid = wgid / nig, fm = gid * WGM, gsz = (nM - fm) < WGM ? (nM - fm) : WGM;
        u.pm = fm + ((wgid % nig) % gsz); u.pn = (wgid % nig) / gsz; return true;
    }
};
template <class Epi, class Prob>
__device__ __forceinline__ void gemm_phase(LAS unsigned char* lds, const Prob& P, const Epi& E, const int wid) {
    const int lane = lane_fresh(), tid = wid * 64 + lane, wr = wid >> 2, wc = wid & 3, fr = lane & 15, fq = lane >> 4;
    constexpr bool F8 = Prob::FP8;
    constexpr int KB = F8 ? 1024 : 2048, nt = KB / 128;
    constexpr bool GA = Prob::GATHER; constexpr bool B16 = Prob::B16; constexpr bool AIL = Prob::AIL;
    constexpr size_t rstepB = (size_t)(B16 ? 128 : 64) * KB, hstepB = (size_t)(B16 ? 8 : HALF) * KB;
    unsigned voB, voA; int gR0; unsigned gC2; const size_t rstep64 = (size_t)64 * KB;
    { int R0, C0; stage_rc(tid * 16, R0, C0); voA = (unsigned)(R0 * KB + C0 * 2);
      if constexpr (AIL) { const int cb = C0 * 2; voA = (unsigned)((R0 >> 5) * 32768 + (R0 & 15) * 2048 + ((R0 >> 4) & 1) * 32 + (cb >> 5) * 64 + (cb & 31)); } gR0 = R0; gC2 = (unsigned)C0 * 2u;
      const int Rb0 = B16 ? 64 * (R0 >> 5) + 16 * ((R0 & 15) >> 2) + 4 * ((R0 >> 4) & 1) + (R0 & 3) : (R0 & ~31) + perm32(R0 & 31); voB = (unsigned)(Rb0 * KB + C0 * 2); }
    const size_t kstep = (size_t)(BK * 2), hstep = (size_t)HALF * KB, kstepA = AIL ? 256 : kstep;
    const unsigned ldsw = (unsigned)wid * 1024u;
    const int aoff = lds_byte(wr * 64 + fr, fq * 8), boff = lds_byte(wc * 32 + fr, fq * 8);
#define PG8_SA(b, h) (((b) * 2 + (h)) * HTB)
#define PG8_SB(b, h) ((4 + (b) * 2 + (h)) * HTB)
#define PG8_STAGE2(bufoff, gbase, vo0, vo1) do { \
        __builtin_amdgcn_global_load_lds((const unsigned*)((const char*)(gbase) + (vo0)), (LAS unsigned*)(lds + (bufoff) + ldsw), 16, 0, 0); \
        __builtin_amdgcn_global_load_lds((const unsigned*)((const char*)(gbase) + (vo1)), (LAS unsigned*)(lds + (bufoff) + ldsw + 8192), 16, 0, 0); } while (0)
#define PG8_STAGE(bufoff, gbase, vo) do { \
        __builtin_amdgcn_global_load_lds((const unsigned*)((const char*)(gbase) + (vo)), (LAS unsigned*)(lds + (bufoff) + ldsw), 16, 0, 0); \
        __builtin_amdgcn_global_load_lds((const unsigned*)((const char*)(gbase) + rstep64 + (vo)), (LAS unsigned*)(lds + (bufoff) + ldsw + 8192), 16, 0, 0); } while (0)
#define PG8_STAGEB(bufoff, gbase) do { \
        __builtin_amdgcn_global_load_lds((const unsigned*)((const char*)(gbase) + (voB)), (LAS unsigned*)(lds + (bufoff) + ldsw), 16, 0, 0); \
        __builtin_amdgcn_global_load_lds((const unsigned*)((const char*)(gbase) + rstepB + (voB)), (LAS unsigned*)(lds + (bufoff) + ldsw + 8192), 16, 0, 0); } while (0)
#define PG8_GOFF(UIX, h) do { if constexpr (GA) { const LAS unsigned* _gp = P.goff + (UIX) * 256 + (h) * 128 + gR0; go0 = _gp[0]; go1 = _gp[64]; } } while (0)
#define PG8_STAGE_A(bufoff, gbase, UIX, h) do { if constexpr (GA) { const unsigned _v0 = go0 + gC2, _v1 = go1 + gC2; PG8_STAGE2(bufoff, gbase, _v0, _v1); } \
        else { PG8_STAGE(bufoff, (gbase) + (size_t)(h) * hstep, voA); } } while (0)
#define PG8_LDA(dst, b, h) do { _Pragma("unroll") for (int m = 0; m < 4; ++m) { const bf16x8 lo_ = *(const LAS bf16x8*)(lds + PG8_SA(b, h) + aoff + m * 2048), hi_ = *(const LAS bf16x8*)(lds + PG8_SA(b, h) + aoff + m * 2048 + 1024); \
        if constexpr (F8) dst##8[m] = cat8(lo_, hi_); else { dst[m][0] = lo_; dst[m][1] = hi_; } } } while (0)
#define PG8_LDB(dst, b, h) do { _Pragma("unroll") for (int n = 0; n < 2; ++n) { const bf16x8 lo_ = *(const LAS bf16x8*)(lds + PG8_SB(b, h) + boff + n * 2048), hi_ = *(const LAS bf16x8*)(lds + PG8_SB(b, h) + boff + n * 2048 + 1024); \
        if constexpr (F8) dst##8[n] = cat8(lo_, hi_); else { dst[n][0] = lo_; dst[n][1] = hi_; } } } while (0)
#define PG8_MMA(ai, bj, At, Bt) do { __builtin_amdgcn_s_setprio(1); _Pragma("unroll") for (int m = 0; m < 4; ++m) _Pragma("unroll") for (int n = 0; n < 2; ++n) { \
        if constexpr (F8) asm volatile("v_mfma_f32_16x16x128_f8f6f4 %0, %1, %2, %0" : "+v"(acc[ai][bj][m][n]) : "v"(Bt##8[n]), "v"(At##8[m])); \
        else { _Pragma("unroll") for (int k = 0; k < 2; ++k) acc[ai][bj][m][n] = __builtin_amdgcn_mfma_f32_16x16x32_bf16(Bt[n][k], At[m][k], acc[ai][bj][m][n], 0, 0, 0); } } \
        __builtin_amdgcn_s_setprio(0); } while (0)
#define PG8_WAIT_V(n) asm volatile("s_waitcnt vmcnt(" #n ")" ::: "memory")
#define PG8_WAIT_L(n) asm volatile("s_waitcnt lgkmcnt(" #n ")" ::: "memory")
#define PG8_BAR __builtin_amdgcn_s_barrier()
#define PG8_SCHED __builtin_amdgcn_sched_barrier(0)
#define PG8_BODY(VA1, VAX) do { \
            PG8_GOFF(VA1, 1); PG8_LDB(B0, 0, 0); PG8_LDB(B1, 0, 1); PG8_SCHED; PG8_LDA(At, 0, 0); PG8_STAGE_A(PG8_SA(1, 1), a1, VA1, 1); \
            PG8_WAIT_V(8); PG8_WAIT_L(0); PG8_BAR; PG8_MMA(0, 0, At, B0); PG8_MMA(0, 1, At, B1); PG8_BAR; PG8_SCHED; \
            PG8_GOFF(VAX, 0); PG8_LDA(At, 0, 1); PG8_STAGEB(PG8_SB(0, 0), b2); PG8_STAGEB(PG8_SB(0, 1), b2 + hstepB); PG8_STAGE_A(PG8_SA(0, 0), a2, VAX, 0); \
            PG8_WAIT_V(8); PG8_WAIT_L(0); PG8_BAR; PG8_MMA(1, 0, At, B0); PG8_MMA(1, 1, At, B1); PG8_BAR; PG8_SCHED; \
            PG8_GOFF(VAX, 1); PG8_LDB(B0, 1, 0); PG8_LDB(B1, 1, 1); PG8_SCHED; PG8_LDA(At, 1, 0); PG8_STAGE_A(PG8_SA(0, 1), a2, VAX, 1); \
            PG8_WAIT_V(8); PG8_WAIT_L(0); PG8_BAR; PG8_MMA(0, 0, At, B0); PG8_MMA(0, 1, At, B1); PG8_BAR; PG8_SCHED; \
            PG8_GOFF(VAX, 0); PG8_LDA(At, 1, 1); PG8_STAGEB(PG8_SB(1, 0), b3); PG8_STAGEB(PG8_SB(1, 1), b3 + hstepB); PG8_STAGE_A(PG8_SA(1, 0), a3, VAX, 0); \
            PG8_WAIT_V(8); PG8_WAIT_L(0); PG8_BAR; PG8_MMA(1, 0, At, B0); PG8_MMA(1, 1, At, B1); PG8_BAR; PG8_SCHED; } while (0)
    LAS int* utab = (LAS int*)(lds + UTAB_OFF);
    if (tid <= MAXU) { Unit t; const bool ok = (tid < MAXU) && P.next(tid, t); utab[tid] = ok ? (t.pm | (t.pn << 16)) : -1; }
    __syncthreads();
    Unit cur, nxt; nxt.pm = 0; nxt.pn = 0; int ui = 0;
    { const int e = __builtin_amdgcn_readfirstlane(utab[0]); if (e < 0) return; cur.pm = e & 0xffff; cur.pn = e >> 16; }
    f32x4 acc[2][2][4][2];
#pragma unroll
    for (int a = 0; a < 2; ++a)
#pragma unroll
        for (int b = 0; b < 2; ++b)
#pragma unroll
            for (int m = 0; m < 4; ++m)
#pragma unroll
                for (int n = 0; n < 2; ++n) acc[a][b][m][n] = (f32x4){0.f, 0.f, 0.f, 0.f};
    bf16x8 At[4][2], B0[2][2], B1[2][2]; v8i At8[4], B08[2], B18[2];
    const char* cA = P.a_base(cur); const char* cB = P.b_base(cur);
    unsigned go0 = 0u, go1 = 0u;
    PG8_STAGEB(PG8_SB(0, 0), cB); PG8_STAGEB(PG8_SB(0, 1), cB + hstepB); PG8_GOFF(0, 0); PG8_STAGE_A(PG8_SA(0, 0), cA, 0, 0); PG8_GOFF(0, 1); PG8_STAGE_A(PG8_SA(0, 1), cA, 0, 1);
    if (wr == 1) PG8_BAR;
    PG8_WAIT_V(2); PG8_BAR;
    PG8_STAGEB(PG8_SB(1, 0), cB + kstep); PG8_GOFF(0, 0); PG8_STAGE_A(PG8_SA(1, 0), cA + kstepA, 0, 0); PG8_STAGEB(PG8_SB(1, 1), cB + hstepB + kstep);
    PG8_WAIT_V(6); PG8_BAR;
    for (;;) {
        const int en = __builtin_amdgcn_readfirstlane(utab[ui + 1]); const bool has_next = en >= 0; nxt.pm = en & 0xffff; nxt.pn = (en >> 16) & 0xffff;
        const char* nA = has_next ? P.a_base(nxt) : cA; const char* nB = has_next ? P.b_base(nxt) : cB;
        int ntr = nt - 2; asm volatile("" : "+s"(ntr));
#pragma nounroll
        for (int t = 0; t < ntr; t += 2) {
            const char* a1 = cA + (size_t)(t + 1) * kstepA;
            const char* a2 = cA + (size_t)(t + 2) * kstepA; const char* b2 = cB + (size_t)(t + 2) * kstep;
            const char* a3 = a2 + kstepA; const char* b3 = b2 + kstep;
            PG8_BODY(ui, ui);
        }
        {
            const char* a1 = cA + (size_t)(nt - 1) * kstepA;
            const char* a2 = nA; const char* b2 = nB; const char* a3 = a2 + kstepA; const char* b3 = b2 + kstep;
            const int uin = has_next ? ui + 1 : ui;
            PG8_BODY(ui, uin);
        }
        if constexpr (F8) asm volatile("s_nop 15\n\ts_nop 15" ::: "memory");
        if (PG8_ALIGN_EPI) { if (wr == 0) PG8_BAR; }
        { const int le = lane_fresh(); E(acc, cur, wr, wc, le & 15, le >> 4, ui); }
        if (!has_next) break;
#pragma unroll
        for (int a = 0; a < 2; ++a)
#pragma unroll
            for (int b = 0; b < 2; ++b)
#pragma unroll
                for (int m = 0; m < 4; ++m)
#pragma unroll
                    for (int n = 0; n < 2; ++n) acc[a][b][m][n] = (f32x4){0.f, 0.f, 0.f, 0.f};
        cur = nxt; cA = nA; cB = nB; ++ui;
        if (PG8_ALIGN_EPI) { if (wr == 1) PG8_BAR; }
    }
    PG8_WAIT_V(0);
    if (!PG8_ALIGN_EPI) { if (wr == 0) PG8_BAR; }
    PG8_BAR;
#undef PG8_BODY
#undef PG8_SA
#undef PG8_SB
#undef PG8_STAGE
#undef PG8_STAGE2
#undef PG8_STAGEB
#undef PG8_STAGE_A
#undef PG8_GOFF
#undef PG8_LDA
#undef PG8_LDB
#undef PG8_MMA
#undef PG8_WAIT_V
#undef PG8_WAIT_L
#undef PG8_BAR
#undef PG8_SCHED
}
}

struct PbPlain : pg8::StaticOrder {
    const bf16* A; const bf16* Bt; int K;
    __device__ __forceinline__ const char* a_base(const pg8::Unit& u) const { return (const char*)(A + (size_t)u.pm * 256 * K); }
    __device__ __forceinline__ const char* b_base(const pg8::Unit& u) const { return (const char*)(Bt + (size_t)u.pn * 256 * K); }
    static constexpr bool GATHER = false, FP8 = false, B16 = false, AIL = false; LAS const unsigned* goff;
};
constexpr int GOFF_OFF = 131072;
__device__ __forceinline__ int pair_token(int t, int r) { if (r < 128) return 128 * t + r; const int sp = 128 * t + r - 128; return sp == 0 ? 1024 : SEQ - sp; }
struct PbDft {
    const bf16* T; const bf16* ET; const bf16* OT; int K, G, c; LAS const unsigned* goff;
    static constexpr bool GATHER = false, FP8 = false, B16 = false, AIL = false;
    __device__ __forceinline__ bool next(int i, pg8::Unit& u) const { const int L = (i >> 1) * G + c; if (L >= 256) return false; u.pm = (L >> 6) + 4 * (i & 1); u.pn = L & 63; return true; }
    __device__ __forceinline__ const char* a_base(const pg8::Unit& u) const { return (const char*)(T + (size_t)u.pm * 256 * K); }
    __device__ __forceinline__ const char* b_base(const pg8::Unit& u) const { return (const char*)((u.pm < 4 ? ET : OT) + (size_t)u.pn * 256 * K); }
};

struct PbMoe1 {
    const unsigned char* H2; const unsigned char* WGU; LAS const unsigned* goff; int K, G, c;
    __device__ __forceinline__ bool next(int i, pg8::Unit& u) const { const int L = i * G + c; if (L >= NPAIR * 8) return false;
        const int e = L >> 8, w = L & 255, x = w & 7, j = w >> 3, b = (j >> 3) * 8 + x; u.pm = b * 16 + e; u.pn = j & 7; return true; }
    __device__ __forceinline__ const char* a_base(const pg8::Unit&) const { return (const char*)H2; }
    __device__ __forceinline__ const char* b_base(const pg8::Unit& u) const { return (const char*)(WGU + ((size_t)(u.pm & 15) * 2048 + u.pn * 256) * 1024); }
    static constexpr bool GATHER = true, FP8 = true, B16 = false, AIL = false;
};
struct PbMoe2 {
    const unsigned char* ACT; const unsigned char* WD; int K, G, c;
    __device__ __forceinline__ bool next(int i, pg8::Unit& u) const { const int L = i * G + c; if (L >= NPAIR * 4) return false;
        const int e = L >> 7, w = L & 127, x = w & 7, j = w >> 3, b = (j >> 2) * 8 + x; u.pm = b * 16 + e; u.pn = j & 3; return true; }
    __device__ __forceinline__ const char* a_base(const pg8::Unit& u) const { return (const char*)(ACT + (size_t)u.pm * 256 * 1024); }
    __device__ __forceinline__ const char* b_base(const pg8::Unit& u) const { return (const char*)(WD + ((size_t)(u.pm & 15) * 1024 + u.pn * 256) * 1024); }
    static constexpr bool GATHER = false, FP8 = true, B16 = true, AIL = true; LAS const unsigned* goff;
};
typedef f32x4 AccT[2][2][4][2];
__device__ __forceinline__ v4u pack8(const f32x4& a, const f32x4& b) { v4u w; w.x = pk2(a.x, a.y); w.y = pk2(a.z, a.w); w.z = pk2(b.x, b.y); w.w = pk2(b.z, b.w); return w; }
struct EpiInProj { LAS unsigned char* lds;
    __device__ __forceinline__ void operator()(const AccT& acc, const pg8::Unit& u, int wr, int wc, int fr, int fq, int) const {
        KArgs ka = kargs(); unsigned char* ws = ka->ws;
        bf16* ET = (bf16*)(ws + WS_ET); bf16* OT = (bf16*)(ws + WS_OT); float* U1024 = (float*)(ws + WS_U1024); const bf16* MAT = (const bf16*)(ws + WS_MAT); const bf16* MBT = (const bf16*)(ws + WS_MBT);
        bf16* Q = (bf16*)(ws + WS_Q); bf16* Kb = (bf16*)(ws + WS_K); bf16* V = (bf16*)(ws + WS_V); const float* qg = ka->in[I_QG]; const float* kg = ka->in[I_KG];
        const int b = u.pm >> 3, t = u.pm & 7;
        if (u.pn < 2) {
            const int gg = 4 * u.pn + wc;
            const bf16* ma = MAT + gg * 4096 + fr * 64 + 8 * fq; const bf16* mb = MBT + gg * 4096 + fr * 64 + 8 * fq;
            bf16x8 fa[4][2], fb[4][2];
#pragma unroll
            for (int db = 0; db < 4; ++db) { fa[db][0] = *(const bf16x8*)(ma + db * 1024); fa[db][1] = *(const bf16x8*)(ma + db * 1024 + 32); fb[db][0] = *(const bf16x8*)(mb + db * 1024); fb[db][1] = *(const bf16x8*)(mb + db * 1024 + 32); }
            LAS unsigned short* tile = (LAS unsigned short*)(lds + GOFF_OFF + 8192 + (wr * 4 + wc) * 1024);
            const int l64 = fr + 16 * fq, dd = l64 >> 2, chn = l64 & 3;
#pragma unroll
            for (int mp = 0; mp < 2; ++mp) {
                bf16x8 ef[2][2], of[2][2], uf[2];
#pragma unroll
                for (int mm = 0; mm < 2; ++mm) { const int m = 2 * mp + mm; const bool tok0 = (t == 0 && wr == 0 && m == 0 && fr == 0);
#pragma unroll
                    for (int bj = 0; bj < 2; ++bj) { f32x4 e0 = acc[0][bj][m][0] + acc[1][bj][m][0], e1 = acc[0][bj][m][1] + acc[1][bj][m][1], o0 = acc[0][bj][m][0] - acc[1][bj][m][0], o1 = acc[0][bj][m][1] - acc[1][bj][m][1];
                        if (tok0) { e0 = acc[0][bj][m][0]; e1 = acc[0][bj][m][1]; o0 = (f32x4){0.f, 0.f, 0.f, 0.f}; o1 = o0; }
                        ef[mm][bj] = __builtin_bit_cast(bf16x8, pack8(e0, e1)); of[mm][bj] = __builtin_bit_cast(bf16x8, pack8(o0, o1));
                        if (m == 0) uf[bj] = __builtin_bit_cast(bf16x8, pack8(acc[1][bj][0][0], acc[1][bj][0][1])); } }
#pragma unroll
                for (int db = 0; db < 4; ++db) {
                    f32x4 em[2], om[2];
#pragma unroll
                    for (int mm = 0; mm < 2; ++mm) { em[mm] = (f32x4){0.f, 0.f, 0.f, 0.f}; om[mm] = em[mm];
                        em[mm] = __builtin_amdgcn_mfma_f32_16x16x32_bf16(fa[db][0], ef[mm][0], em[mm], 0, 0, 0); em[mm] = __builtin_amdgcn_mfma_f32_16x16x32_bf16(fa[db][1], ef[mm][1], em[mm], 0, 0, 0);
                        om[mm] = __builtin_amdgcn_mfma_f32_16x16x32_bf16(fb[db][0], of[mm][0], om[mm], 0, 0, 0); om[mm] = __builtin_amdgcn_mfma_f32_16x16x32_bf16(fb[db][1], of[mm][1], om[mm], 0, 0, 0); }
                    const unsigned o = (unsigned)(((unsigned)b * 512u + gg * 64 + 16 * db + dd) * 1024u + 128 * t + wr * 64 + 32 * mp + 8 * chn);
                    LAS unsigned short* tw = tile + (4 * fq) * 32 + fr;
                    tw[0] = (unsigned short)f2bf(em[0].x); tw[32] = (unsigned short)f2bf(em[0].y); tw[64] = (unsigned short)f2bf(em[0].z); tw[96] = (unsigned short)f2bf(em[0].w);
                    tw[16] = (unsigned short)f2bf(em[1].x); tw[48] = (unsigned short)f2bf(em[1].y); tw[80] = (unsigned short)f2bf(em[1].z); tw[112] = (unsigned short)f2bf(em[1].w);
                    asm volatile("" ::: "memory");
                    { const v4u ve = *(const LAS v4u*)(tile + dd * 32 + 8 * chn); asm volatile("" ::: "memory"); *(v4u*)(ET + o) = ve; }
                    tw[0] = (unsigned short)f2bf(om[0].x); tw[32] = (unsigned short)f2bf(om[0].y); tw[64] = (unsigned short)f2bf(om[0].z); tw[96] = (unsigned short)f2bf(om[0].w);
                    tw[16] = (unsigned short)f2bf(om[1].x); tw[48] = (unsigned short)f2bf(om[1].y); tw[80] = (unsigned short)f2bf(om[1].z); tw[112] = (unsigned short)f2bf(om[1].w);
                    asm volatile("" ::: "memory");
                    { const v4u vo = *(const LAS v4u*)(tile + dd * 32 + 8 * chn); asm volatile("" ::: "memory"); *(v4u*)(OT + o) = vo; }
                    if (mp == 0 && t == 0 && wr == 0) {
                        f32x4 um = {0.f, 0.f, 0.f, 0.f};
                        um = __builtin_amdgcn_mfma_f32_16x16x32_bf16(fa[db][0], uf[0], um, 0, 0, 0); um = __builtin_amdgcn_mfma_f32_16x16x32_bf16(fa[db][1], uf[1], um, 0, 0, 0);
                        if (fr == 0) *(f32x4*)(U1024 + b * 512 + gg * 64 + 16 * db + 4 * fq) = um; }
                } }
        } else {
            const int hg = (u.pn - 2) * 4 + wc;
            const bool isq = hg < 8, isk = (hg >= 8 && hg < 10);
            const float* gain = isq ? qg : kg;
            f32x4 gv[2][2];
#pragma unroll
            for (int bj = 0; bj < 2; ++bj)
#pragma unroll
                for (int n = 0; n < 2; ++n) gv[bj][n] = *(const f32x4*)(gain + 32 * bj + 8 * fq + 4 * n);
            bf16* base; int ld, hoff;
            if (isq) { base = Q; ld = 512; hoff = hg * 64; } else if (isk) { base = Kb; ld = 128; hoff = (hg - 8) * 64; } else { base = V; ld = 128; hoff = (hg - 10) * 64; }
#pragma unroll
            for (int ai = 0; ai < 2; ++ai)
#pragma unroll
                for (int m = 0; m < 4; ++m) { float ss = 0.f;
#pragma unroll
                    for (int bj = 0; bj < 2; ++bj)
#pragma unroll
                        for (int n = 0; n < 2; ++n) { const f32x4 v = acc[ai][bj][m][n]; ss += (v.x * v.x + v.y * v.y) + (v.z * v.z + v.w * v.w); }
                    ss += __shfl_xor(ss, 16); ss += __shfl_xor(ss, 32);
                    const float rs = (isq || isk) ? 1.f / sqrtf(ss * (1.f / 64.f) + EPS) : 1.f;
                    const int tok = b * SEQ + pair_token(t, ai * 128 + wr * 64 + m * 16 + fr);
                    bf16* rowp = base + (unsigned)((unsigned)tok * ld + hoff + 8 * fq);
#pragma unroll
                    for (int bj = 0; bj < 2; ++bj) { f32x4 v0 = acc[ai][bj][m][0] * rs, v1 = acc[ai][bj][m][1] * rs; if (isq || isk) { v0 = v0 * gv[bj][0]; v1 = v1 * gv[bj][1]; } *(v4u*)(rowp + 32 * bj) = pack8(v0, v1); } }
        }
    }
};
struct EpiDft {
    __device__ __forceinline__ void operator()(const AccT& acc, const pg8::Unit& u, int wr, int wc, int fr, int fq, int) const {
        KArgs ka = kargs(); unsigned char* ws = ka->ws; bf16* Y = (bf16*)(ws + WS_Y); float* PA = (float*)(ws + WS_PA); const float* U1024 = (const float*)(ws + WS_U1024); const float* bfv = ka->in[I_BF];
        const int b = u.pn >> 1; const bool cosr = u.pm < 4; const float sgn = (fr & 1) ? -1.f : 1.f;
        float* pa = PA + (size_t)((u.pm & 3) * 64 + u.pn) * 65536;
        bf16* yb = Y + (unsigned)((unsigned)b * SEQ * KOUT);
#pragma unroll
        for (int bj = 0; bj < 2; ++bj) { const int cl = bj * 128 + wc * 32 + 8 * fq, ch = (u.pn & 1) * 256 + cl;
            f32x4 ua, ub;
            if (cosr) { ua = *(const f32x4*)(U1024 + b * 512 + ch) * sgn; ub = *(const f32x4*)(U1024 + b * 512 + ch + 4) * sgn; }
            else { ua = *(const f32x4*)(bfv + ch); ub = *(const f32x4*)(bfv + ch + 4); }
#pragma unroll
            for (int ai = 0; ai < 2; ++ai)
#pragma unroll
                for (int m = 0; m < 4; ++m) { const int rl = ai * 128 + wr * 64 + m * 16 + fr, k = (u.pm & 3) * 256 + rl;
                    float* pp = pa + rl * 256 + cl;
                    if (cosr) { *(f32x4*)pp = acc[ai][bj][m][0] + ua; *(f32x4*)(pp + 4) = acc[ai][bj][m][1] + ub; }
                    else { const f32x4 p0 = *(const f32x4*)pp + ua, p1 = *(const f32x4*)(pp + 4) + ub;
                        *(v4u*)(yb + (unsigned)(k * KOUT + ch)) = pack8(p0 + acc[ai][bj][m][0], p1 + acc[ai][bj][m][1]);
                        if (k > 0) *(v4u*)(yb + (unsigned)((SEQ - k) * KOUT + ch)) = pack8(p0 - acc[ai][bj][m][0], p1 - acc[ai][bj][m][1]); } } }
    }
};
struct EpiOut {
    __device__ __forceinline__ void operator()(const AccT& acc, const pg8::Unit& u, int wr, int wc, int fr, int fq, int) const {
        KArgs ka = kargs(); unsigned char* ws = ka->ws; bf16* DELTA = (bf16*)(ws + WS_DELTA);
        const int row0 = u.pm * 256 + wr * 64 + fr, b = row0 / SEQ, col0 = u.pn * 256 + wc * 32 + 8 * fq;
        const float* g1p = (const float*)(ws + WS_MOD) + b * NADA + 2 * DM + col0;
#pragma unroll
        for (int bj = 0; bj < 2; ++bj) { const f32x4 ga = *(const f32x4*)(g1p + bj * 128), gb = *(const f32x4*)(g1p + bj * 128 + 4);
#pragma unroll
            for (int ai = 0; ai < 2; ++ai)
#pragma unroll
                for (int m = 0; m < 4; ++m) { const unsigned off = (unsigned)(row0 + ai * 128 + m * 16) * DM + col0;
                    __builtin_nontemporal_store(pack8(ga * acc[ai][bj][m][0], gb * acc[ai][bj][m][1]), (v4u*)(DELTA + off + bj * 128)); } }
    }
};
__device__ __forceinline__ float silu_mul(float g, float u) { return g * u * __builtin_amdgcn_rcpf(1.f + __builtin_amdgcn_exp2f(-LOG2E * g)); }
struct EpiSwiGLU { static constexpr bool SPLIT = false;
    __device__ __forceinline__ void operator()(const AccT& acc, const pg8::Unit& u, int wr, int wc, int fr, int fq, int) const {
        unsigned char* ACT = kargs()->ws + WS_ACT;
#pragma unroll
        for (int ai = 0; ai < 2; ++ai)
#pragma unroll
            for (int mp = 0; mp < 2; ++mp) { v2u w[2];
#pragma unroll
                for (int mm = 0; mm < 2; ++mm) { const int m = 2 * mp + mm; f32x4 o[2];
#pragma unroll
                    for (int n = 0; n < 2; ++n) { const f32x4 g = acc[ai][0][m][n] * W8I, up = acc[ai][1][m][n] * W8I;
#pragma unroll
                        for (int j = 0; j < 4; ++j) o[n][j] = silu_mul(g[j], up[j]); }
                    w[mm].x = pk4_fp8(o[0].x, o[0].y, o[0].z, o[0].w); w[mm].y = pk4_fp8(o[1].x, o[1].y, o[1].z, o[1].w); }
                const v2u sx = __builtin_amdgcn_permlane16_swap(w[0].x, w[1].x, false, false), sy = __builtin_amdgcn_permlane16_swap(w[0].y, w[1].y, false, false);
                v4u ov; ov.x = sx[0]; ov.y = sy[0]; ov.z = sx[1]; ov.w = sy[1];
                unsigned char* rowp = ACT + (unsigned)(((unsigned)u.pm * 8u + (unsigned)(ai * 4 + wr * 2 + mp)) * 32768u + (unsigned)fr * 2048u + (unsigned)(u.pn * 4 + wc) * 64u + (unsigned)(fq & 1) * 32u + 16u * (unsigned)(fq >> 1));
                __builtin_nontemporal_store(ov, (v4u*)rowp); }
    }
};
struct EpiY { static constexpr bool SPLIT = false; LAS const float* gate;
    __device__ __forceinline__ void operator()(const AccT& acc, const pg8::Unit& u, int wr, int wc, int fr, int fq, int ui) const {
        unsigned char* YB = kargs()->ws + WS_YB;
#pragma unroll
        for (int ai = 0; ai < 2; ++ai)
#pragma unroll
            for (int m = 0; m < 4; ++m) { const int rl = ai * 128 + wr * 64 + m * 16 + fr; const float gt = gate[ui * 256 + rl]; unsigned char* rowp = YB + (unsigned)(((unsigned)u.pm * 256u + (unsigned)rl) * DM + u.pn * 256 + wc * 64 + 16 * fq);
                const f32x4 v0 = acc[ai][0][m][0] * gt, v1 = acc[ai][0][m][1] * gt, v2 = acc[ai][1][m][0] * gt, v3 = acc[ai][1][m][1] * gt; v4u w;
                w.x = pk4_fp8(v0.x, v0.y, v0.z, v0.w); w.y = pk4_fp8(v1.x, v1.y, v1.z, v1.w); w.z = pk4_fp8(v2.x, v2.y, v2.z, v2.w); w.w = pk4_fp8(v3.x, v3.y, v3.z, v3.w);
                __builtin_nontemporal_store(w, (v4u*)rowp); }
    }
};

typedef float f32x16 __attribute__((ext_vector_type(16)));
constexpr int AT_KL = 0, AT_KSTRIDE = 144;
constexpr int AT_VT = 384 * 144, AT_VSTRIDE = 776;
constexpr int AT_TB = AT_VT + 64 * 776;
__device__ __forceinline__ void attn_phase(KArgs a, LAS unsigned char* lds, int tid, int wave, int lane, int G) {
    const bf16* Q = (const bf16*)(a->ws + WS_Q); const bf16* Kb = (const bf16*)(a->ws + WS_K); const bf16* V = (const bf16*)(a->ws + WS_V); bf16* Y = (bf16*)(a->ws + WS_Y);
    LAS float* TB = (LAS float*)(lds + AT_TB);
    for (int i = tid; i < 8 * 257; i += NTHR) { const int h = i / 257, ii = i % 257; TB[h * 260 + ii] = a->in[I_RELB][t5_bucket(ii - 128) * 8 + h] * 8.f; }
    const int l31 = lane & 31, hh = lane >> 5;
    const float c1 = 0.125f * LOG2E;
    for (int it = blockIdx.x; it < NB * 2 * 4; it += G) {
        const int b = it >> 3, kh = (it >> 2) & 1, qs0 = (it & 3) * 512;
        __syncthreads();
        for (int c = tid; c < 3072; c += NTHR) { const int r = c >> 3, ch = c & 7, key = qs0 - 128 + r; v4u val = {0u, 0u, 0u, 0u};
            if (key >= 0 && key < SEQ) val = *(const v4u*)(Kb + ((size_t)b * SEQ + key) * 128 + kh * 64 + ch * 8);
            *(LAS v4u*)(lds + AT_KL + r * AT_KSTRIDE + ch * 16) = val; }
        for (int c = tid; c < 1536; c += NTHR) { const int kp = c % 192, cd = c / 192, r = 2 * kp, key = qs0 - 128 + r; v4u v0 = {0u, 0u, 0u, 0u}, v1 = {0u, 0u, 0u, 0u};
            if (key >= 0 && key < SEQ) { const bf16* vp = V + ((size_t)b * SEQ + key) * 128 + kh * 64 + cd * 8; v0 = *(const v4u*)vp; v1 = *(const v4u*)(vp + 128); }
            const unsigned w0[4] = {v0.x, v0.y, v0.z, v0.w}, w1[4] = {v1.x, v1.y, v1.z, v1.w};
#pragma unroll
            for (int j = 0; j < 4; ++j) {
                *(LAS unsigned*)(lds + AT_VT + (8 * cd + 2 * j) * AT_VSTRIDE + r * 2) = (w0[j] & 0xffffu) | (w1[j] << 16);
                *(LAS unsigned*)(lds + AT_VT + (8 * cd + 2 * j + 1) * AT_VSTRIDE + r * 2) = (w0[j] >> 16) | (w1[j] & 0xffff0000u); } }
        __syncthreads();
      for (int bi = 0; bi < 4; ++bi) {
        const int qs = qs0 + 128 * bi;
        const int nkey0 = qs0 + 256 + 128 * bi;
        v4u pk0 = {0u, 0u, 0u, 0u}, pk1 = pk0, pv0 = pk0, pv1 = pk0;
        if (bi < 3 && nkey0 < SEQ) { const bf16* kp_ = Kb + ((size_t)b * SEQ + nkey0 + (tid >> 3)) * 128 + kh * 64 + (tid & 7) * 8; pk0 = *(const v4u*)kp_; pk1 = *(const v4u*)(kp_ + 64 * 128);
            const bf16* vp_ = V + ((size_t)b * SEQ + nkey0 + 2 * (tid & 63)) * 128 + kh * 64 + (tid >> 6) * 8; pv0 = *(const v4u*)vp_; pv1 = *(const v4u*)(vp_ + 128); }
        const int r4 = wave >> 1, half = wave & 1, hq = kh * 4 + r4, q0 = qs + 64 * half;
        bf16x8 qf[2][4];
#pragma unroll
        for (int j = 0; j < 2; ++j)
#pragma unroll
            for (int ks = 0; ks < 4; ++ks) qf[j][ks] = *(const bf16x8*)(Q + ((size_t)b * SEQ + q0 + 32 * j + l31) * 512 + hq * 64 + 16 * ks + 8 * hh);
        float mrun[2], lrun[2]; f32x16 O[2][2];
        { const float sk = a->in[I_SINK][hq] * LOG2E; mrun[0] = sk; mrun[1] = sk; lrun[0] = hh == 0 ? 1.f : 0.f; lrun[1] = lrun[0]; }
#pragma unroll
        for (int d = 0; d < 2; ++d)
#pragma unroll
            for (int j = 0; j < 2; ++j)
#pragma unroll
                for (int i = 0; i < 16; ++i) O[d][j][i] = 0.f;
        const LAS float* tbh = TB + hq * 260;
        for (int kk = 0; kk < 10; ++kk) {
            const int key0 = q0 - 128 + 32 * kk;
            if (key0 + 31 < 0 || key0 >= SEQ) continue;
            const int rel = 128 * bi + 64 * half + 32 * kk, lrow = ((rel >> 7) % 3) * 128 + (rel & 127);
            const bool edge = (key0 < 0) || (key0 + 31 >= SEQ);
            bf16x8 kf[4];
#pragma unroll
            for (int ks = 0; ks < 4; ++ks) kf[ks] = *(const LAS bf16x8*)(lds + AT_KL + (lrow + l31) * AT_KSTRIDE + (16 * ks + 8 * hh) * 2);
            bf16x8 pf[2][2]; bool live[2];
#pragma unroll
            for (int j = 0; j < 2; ++j) {
                const int dk = kk - j;
                live[j] = (dk >= 0 && dk <= 8);
                if (!live[j]) continue;
                f32x16 S;
                const int ib = 32 * dk - l31 + 4 * hh;
                const bool interior = (dk >= 1 && dk <= 7 && !edge);
                if (interior) { const LAS float* tp = tbh + ib;
#pragma unroll
                    for (int i = 0; i < 16; ++i) S[i] = tp[(i & 3) + 8 * (i >> 2)];
                } else { int ibm = ib; asm volatile("" : "+v"(ibm));
#pragma unroll
                    for (int i = 0; i < 16; ++i) { const int idx = ibm + (i & 3) + 8 * (i >> 2); S[i] = tbh[idx < 0 ? 0 : (idx > 256 ? 256 : idx)]; }
                }
#pragma unroll
                for (int ks = 0; ks < 4; ++ks) S = __builtin_amdgcn_mfma_f32_32x32x16_bf16(kf[ks], qf[j][ks], S, 0, 0, 0);
                if (!interior) { int ibm = ib, kb = key0 + 4 * hh; asm volatile("" : "+v"(ibm), "+v"(kb));
#pragma unroll
                    for (int i = 0; i < 16; ++i) { const int ro = (i & 3) + 8 * (i >> 2), idx = ibm + ro, key = kb + ro;
                        const bool valid = (idx >= 0) && (idx <= 256) && (key >= 0) && (key < SEQ); S[i] = valid ? S[i] : -INFINITY; }
                }
                float mx = S[0];
#pragma unroll
                for (int i = 1; i < 16; ++i) mx = fmaxf(mx, S[i]);
                mx = fmaxf(mx, __shfl_xor(mx, 32)) * c1;
                if (__any(mx > mrun[j] + 8.f)) {
                    const float mn = fmaxf(mrun[j], mx), al = __builtin_amdgcn_exp2f(mrun[j] - mn); mrun[j] = mn; lrun[j] *= al;
#pragma unroll
                    for (int d = 0; d < 2; ++d)
#pragma unroll
                        for (int i = 0; i < 16; ++i) O[d][j][i] *= al;
                }
                const float nm = -mrun[j]; float rs = 0.f;
#pragma unroll
                for (int i = 0; i < 16; ++i) { const float p = __builtin_amdgcn_exp2f(__builtin_fmaf(S[i], c1, nm)); S[i] = p; rs += p; }
                lrun[j] += rs;
#pragma unroll
                for (int s2 = 0; s2 < 2; ++s2) { v4u w; w.x = pk2(S[8 * s2], S[8 * s2 + 1]); w.y = pk2(S[8 * s2 + 2], S[8 * s2 + 3]); w.z = pk2(S[8 * s2 + 4], S[8 * s2 + 5]); w.w = pk2(S[8 * s2 + 6], S[8 * s2 + 7]); pf[j][s2] = __builtin_bit_cast(bf16x8, w); }
            }
#pragma unroll
            for (int d = 0; d < 2; ++d)
#pragma unroll
                for (int s2 = 0; s2 < 2; ++s2) { const LAS unsigned char* vp = lds + AT_VT + (32 * d + l31) * AT_VSTRIDE + (lrow + 16 * s2 + 4 * hh) * 2;
                    const v2u lo = *(const LAS v2u*)vp, hi = *(const LAS v2u*)(vp + 16); v4u w; w.x = lo.x; w.y = lo.y; w.z = hi.x; w.w = hi.y; const bf16x8 vf = __builtin_bit_cast(bf16x8, w);
#pragma unroll
                    for (int j = 0; j < 2; ++j) if (live[j]) O[d][j] = __builtin_amdgcn_mfma_f32_32x32x16_bf16(vf, pf[j][s2], O[d][j], 0, 0, 0); }
        }
#pragma unroll
        for (int j = 0; j < 2; ++j) { const float lt = lrun[j] + __shfl_xor(lrun[j], 32); const float inv = 1.f / lt;
            bf16* yp = Y + ((size_t)b * SEQ + q0 + 32 * j + l31) * KOUT + 512 + hq * 64 + 4 * hh;
#pragma unroll
            for (int d = 0; d < 2; ++d)
#pragma unroll
                for (int g4 = 0; g4 < 4; ++g4) { v2u w; w.x = pk2(O[d][j][4 * g4] * inv, O[d][j][4 * g4 + 1] * inv); w.y = pk2(O[d][j][4 * g4 + 2] * inv, O[d][j][4 * g4 + 3] * inv); *(v2u*)(yp + 32 * d + 8 * g4) = w; } }
        if (bi < 3) {
            __syncthreads();
            const int slot = bi % 3, r0 = slot * 128 + (tid >> 3);
            *(LAS v4u*)(lds + AT_KL + r0 * AT_KSTRIDE + (tid & 7) * 16) = pk0; *(LAS v4u*)(lds + AT_KL + (r0 + 64) * AT_KSTRIDE + (tid & 7) * 16) = pk1;
            const int cd = tid >> 6, rr = slot * 128 + 2 * (tid & 63); const unsigned w0[4] = {pv0.x, pv0.y, pv0.z, pv0.w}, w1[4] = {pv1.x, pv1.y, pv1.z, pv1.w};
#pragma unroll
            for (int j = 0; j < 4; ++j) {
                *(LAS unsigned*)(lds + AT_VT + (8 * cd + 2 * j) * AT_VSTRIDE + rr * 2) = (w0[j] & 0xffffu) | (w1[j] << 16);
                *(LAS unsigned*)(lds + AT_VT + (8 * cd + 2 * j + 1) * AT_VSTRIDE + rr * 2) = (w0[j] >> 16) | (w1[j] & 0xffff0000u); }
            __syncthreads();
        }
      }
    }
    __syncthreads();
}

__device__ __forceinline__ void ph2_inproj(KArgs args, LAS unsigned char* lds, int tid, int G, int bx, int wave) {
    unsigned char* ws = args->ws;
    PbPlain P; P.init(MTOK, NPROJ, G, bx); P.A = (const bf16*)(ws + WS_H); P.Bt = (const bf16*)(ws + WS_WIN); P.K = DM; P.goff = nullptr;
    EpiInProj E{lds};
    pg8::gemm_phase(lds, P, E, wave);
}
__device__ __forceinline__ void ph3_dft(KArgs args, LAS unsigned char* lds, int G, int bx, int wave, int lane, int vcu) {
    unsigned char* ws = args->ws;
    PbDft P; P.T = (const bf16*)(ws + WS_T); P.ET = (const bf16*)(ws + WS_ET); P.OT = (const bf16*)(ws + WS_OT); P.K = 1024; P.G = G; P.c = bx; P.goff = nullptr;
    EpiDft E;
    pg8::gemm_phase(lds, P, E, wave);
    { const bf16* ET = (const bf16*)(ws + WS_ET); const float* U1024 = (const float*)(ws + WS_U1024); const float* bfv = args->in[I_BF]; bf16* Y = (bf16*)(ws + WS_Y);
      const int gw = vcu * NWAVES + wave, NGW = G * NWAVES;
      for (int row0 = gw * 8; row0 < NB * 512; row0 += NGW * 8) {
          v4u d[8][2]; float sacc[8];
#pragma unroll
          for (int q = 0; q < 8; ++q) ld_row_bf(ET + (size_t)(row0 + q) * 1024, lane, d[q]);
#pragma unroll
          for (int q = 0; q < 8; ++q) { sacc[q] = 0.f;
#pragma unroll
              for (int h = 0; h < 2; ++h) sacc[q] += (bf2f(d[q][h].x & 0xffffu) - bf2f(d[q][h].x >> 16)) + (bf2f(d[q][h].y & 0xffffu) - bf2f(d[q][h].y >> 16)) + (bf2f(d[q][h].z & 0xffffu) - bf2f(d[q][h].z >> 16)) + (bf2f(d[q][h].w & 0xffffu) - bf2f(d[q][h].w >> 16)); }
#pragma unroll
          for (int o = 1; o < 64; o <<= 1) {
#pragma unroll
              for (int q = 0; q < 8; ++q) sacc[q] += __shfl_xor(sacc[q], o); }
          float mine = sacc[0];
#pragma unroll
          for (int q = 1; q < 8; ++q) mine = (lane == q) ? sacc[q] : mine;
          if (lane < 8) { const int row = row0 + lane; Y[((size_t)(row >> 9) * SEQ + 1024) * KOUT + (row & 511)] = (bf16)f2bf(mine + U1024[row] + bfv[row & 511]); } } }
}
__device__ __forceinline__ void ph4_out(KArgs args, LAS unsigned char* lds, int G, int bx, int wave) {
    unsigned char* ws = args->ws;
    PbPlain P; P.init(MTOK, DM, G, bx); P.A = (const bf16*)(ws + WS_Y); P.Bt = (const bf16*)(ws + WS_WOUT); P.K = KOUT;
    EpiOut E;
    pg8::gemm_phase(lds, P, E, wave);
}
__device__ __forceinline__ void ph7_moe1(KArgs args, LAS unsigned char* lds, int tid, int G, int bx, int wave) {
    unsigned char* ws = args->ws;
    PbMoe1 P; P.H2 = ws + WS_H2; P.WGU = ws + WS_WGU; P.goff = (LAS const unsigned*)(lds + GOFF_OFF); P.K = DM; P.G = G; P.c = bx;
    { const int* IDX = (const int*)(ws + WS_IDX); LAS unsigned* go = (LAS unsigned*)(lds + GOFF_OFF); pg8::Unit u;
      for (int i = 0; i < 16 && P.next(i, u); ++i) for (int r = tid; r < 256; r += NTHR) go[i * 256 + r] = (unsigned)(((u.pm >> 4) * SEQ + IDX[u.pm * CAP + r]) * DM);
      __syncthreads(); }
    EpiSwiGLU E;
    pg8::gemm_phase(lds, P, E, wave);
}
__device__ __forceinline__ void ph8_moe2(KArgs args, LAS unsigned char* lds, int G, int bx, int wave) {
    unsigned char* ws = args->ws;
    PbMoe2 P; P.ACT = ws + WS_ACT; P.WD = ws + WS_WD; P.goff = nullptr; P.K = DEXP; P.G = G; P.c = bx;
    { const float* GATE = (const float*)(ws + WS_GATE); LAS float* gl = (LAS float*)(lds + GOFF_OFF); pg8::Unit u;
      for (int i = 0; i < 8 && P.next(i, u); ++i) for (int r = wave * 64 + lane_fresh(); r < 256; r += NTHR) gl[i * 256 + r] = GATE[u.pm * CAP + r];
      __syncthreads(); }
    EpiY E{(LAS const float*)(lds + GOFF_OFF)};
    pg8::gemm_phase(lds, P, E, wave);
}

constexpr int LDSCTL_OFF = 147456;
constexpr int CW_BAR = 4096;
__global__ void __launch_bounds__(NTHR, 2) mega(Args args) {
    extern __shared__ __attribute__((aligned(16))) unsigned char lds_raw[];
    LAS unsigned char* lds = (LAS unsigned char*)lds_raw;
    const int wave = __builtin_amdgcn_readfirstlane(threadIdx.x >> 6);
#define LANE lane_fresh()
#define TID (wave * 64 + lane_fresh())
    const int G = gridDim.x; const int bx = blockIdx.x; const int vcu = (G % 8 == 0) ? (bx % 8) * (G / 8) + bx / 8 : bx;
    const int lo = args.ph_lo, hi = args.ph_hi;
    unsigned char* ws = args.ws;
    for (int u = TID; u < 128; u += NTHR) ((LAS unsigned*)(lds + LDSCTL_OFF))[u] = 0u;
    __syncthreads();
    XcdBarrier bar; bar.bar = (unsigned*)(ws + WS_CTL) + CW_BAR; bar.x = 0; bar.st = nullptr;
    if (hi - lo > 1) bar = xcd_barrier_post((unsigned*)(ws + WS_CTL) + CW_BAR, (volatile LAS unsigned*)(lds + LDSCTL_OFF), wave);
#ifndef PROBE_DUP
#define PROBE_DUP -1
#endif
#define IN(k) (lo <= (k) && (k) < hi)
#define SEAM(k) do { if (IN(k) && IN((k) + 1)) xcd_barrier(bar, wave); } while (0)
#define PHASE(k, ...) do { if (IN(k)) { __VA_ARGS__; if (PROBE_DUP == (k)) { xcd_barrier(bar, wave); __VA_ARGS__; } } SEAM(k); } while (0)
    PHASE(0, p0_mod(kargs(), lds, TID, G); p0_maps(kargs(), lds, TID, G); p0_rest(kargs(), lds, TID, wave, LANE, vcu, G));
    PHASE(1, p1_h(kargs(), wave, LANE, vcu, G));
    PHASE(2, ph2_inproj(kargs(), lds, TID, G, bx, wave));
    PHASE(3, if (kargs()->li != 2) ph3_dft(kargs(), lds, G, bx, wave, LANE, vcu); if (kargs()->li != 1) attn_phase(kargs(), lds, TID, wave, LANE, G));
    PHASE(4, ph4_out(kargs(), lds, G, bx, wave));
    PHASE(5, p5_router(kargs(), lds, TID, wave, LANE, vcu, G));
    PHASE(6, p6_topk(kargs(), lds, TID, G));
    PHASE(7, ph7_moe1(kargs(), lds, TID, G, bx, wave));
    PHASE(8, ph8_moe2(kargs(), lds, G, bx, wave));
    PHASE(9, p9_combine(kargs(), wave, LANE, vcu, G));
#undef PHASE
#undef IN
#undef SEAM
}

#ifndef MK_CUTS
#define MK_CUTS 1
#endif
extern "C" void kernel_launch(void* const* d_in, const int* in_sizes, int n_in, void* d_out, int out_size, void* d_ws, size_t ws_size, hipStream_t stream) {
    static int grid = 0;
    if (grid == 0) {
        if (n_in != 18 || in_sizes[0] != MTOK * DM || out_size != MTOK * DM || ws_size < WS_END) { fprintf(stderr, "kernel_launch: unexpected shapes (n_in %d, in0 %d, out %d, ws %zu)\n", n_in, n_in > 0 ? in_sizes[0] : -1, out_size, ws_size); grid = -1; return; }
        int dev = 0, cus = 0;
        if (hipGetDevice(&dev) != hipSuccess || hipDeviceGetAttribute(&cus, hipDeviceAttributeMultiprocessorCount, dev) != hipSuccess) { grid = -1; return; }
        if (hipFuncSetAttribute((const void*)mega, hipFuncAttributeMaxDynamicSharedMemorySize, LDS_BYTES) != hipSuccess) { fprintf(stderr, "kernel_launch: hipFuncSetAttribute failed\n"); grid = -1; return; }
        (void)hipGetLastError();
        grid = cus;
    }
    if (grid < 0) return;
    (void)hipMemsetAsync((char*)d_ws + WS_CTL, 0, 65536, stream);
    Args a{};
    for (int i = 0; i < 18; ++i) a.in[i] = (const float*)d_in[i];
    a.out = (float*)d_out; a.ws = (unsigned char*)d_ws;
    auto run = [&](int lo, int hi) { Args b = a; b.ph_lo = lo; b.ph_hi = hi; b.li = 0; hipLaunchKernelGGL(mega, dim3(grid), dim3(NTHR), LDS_BYTES, stream, b); };
#ifndef PROBE_HOST_DUP
#define PROBE_HOST_DUP -1
#endif
    if (MK_CUTS == 1) run(0, 10);
    else for (int p = 0; p < 10; ++p) { run(p, p + 1);
        if (PROBE_HOST_DUP == p) run(p, p + 1);
        if (p == 3 && (PROBE_HOST_DUP == 31 || PROBE_HOST_DUP == 32)) { Args b = a; b.ph_lo = 3; b.ph_hi = 4; b.li = PROBE_HOST_DUP - 30; hipLaunchKernelGGL(mega, dim3(grid), dim3(NTHR), LDS_BYTES, stream, b); } }
}
```

```cpp
#include <hip/hip_runtime.h>
#include <cstdio>
#include <cstdint>

#define LAS __attribute__((address_space(3)))
#define GAS __attribute__((address_space(1)))
typedef unsigned short bf16;
typedef unsigned v4u __attribute__((ext_vector_type(4)));
typedef unsigned v2u __attribute__((ext_vector_type(2)));
typedef float f32x4 __attribute__((ext_vector_type(4)));
typedef short bf16x8 __attribute__((ext_vector_type(8)));

constexpr int NB = 32, SEQ = 2048, DM = 1024, MTOK = NB * SEQ;
constexpr int NPROJ = 1280, FW = 512, KOUT = 1024;
constexpr int NEXP = 16, CAP = 256, DEXP = 1024, NPAIR = NB * NEXP, NSLOT = NPAIR * CAP;
constexpr int NADA = 6 * DM;
constexpr float EPS = 1e-6f;
constexpr float LOG2E = 1.4426950408889634f;

constexpr size_t MiB = 1u << 20;
constexpr size_t WS_CTL = 0, CTL_BYTES = 1 * MiB;
constexpr size_t WS_MOD = 1 * MiB;
constexpr size_t WS_MAT = 1 * MiB + 896 * 1024;
constexpr size_t WS_MBT = 1 * MiB + 960 * 1024;
constexpr size_t WS_WIN = 2 * MiB;
constexpr size_t WS_WOUT = 5 * MiB;
constexpr size_t WS_T = 8 * MiB;
constexpr size_t WS_WGU = 16 * MiB;
constexpr size_t WS_WD = 80 * MiB;
constexpr size_t WS_AFF = 112 * MiB;
constexpr size_t WS_IDX = 116 * MiB;
constexpr size_t WS_GATE = 116 * MiB + 512 * 1024;
constexpr size_t WS_INV = 117 * MiB;
constexpr size_t WS_K = 122 * MiB;
constexpr size_t WS_V = 138 * MiB;
constexpr size_t WS_H = 160 * MiB;
constexpr size_t WS_ET = 288 * MiB;
constexpr size_t WS_OT = 320 * MiB;
constexpr size_t WS_U1024 = 1 * MiB + 832 * 1024;
constexpr size_t WS_Q = 352 * MiB;
constexpr size_t WS_YB = 160 * MiB;
constexpr size_t WS_Y = 416 * MiB;
constexpr size_t WS_PA = 544 * MiB;
constexpr size_t WS_H2 = 416 * MiB;
constexpr size_t WS_ACT = 608 * MiB;
constexpr size_t WS_DELTA = 864 * MiB;
constexpr size_t WS_END = 992 * MiB;

typedef __bf16 bf16x2_t __attribute__((ext_vector_type(2)));
__device__ __forceinline__ unsigned f2bf(float f) { return (unsigned)__builtin_bit_cast(unsigned short, (__bf16)f); }
__device__ __forceinline__ unsigned pk2(float lo, float hi) { bf16x2_t v; v.x = (__bf16)lo; v.y = (__bf16)hi; return __builtin_bit_cast(unsigned, v); }
__device__ __forceinline__ unsigned pk4_fp8(float a, float b, float c, float d) { int w = 0; w = __builtin_amdgcn_cvt_pk_fp8_f32(a, b, w, false); w = __builtin_amdgcn_cvt_pk_fp8_f32(c, d, w, true); return (unsigned)w; }
constexpr float W8S = 32.f, W8I = 1.f / 32.f;
__device__ __forceinline__ float bf2f(unsigned b) { return __builtin_bit_cast(float, b << 16); }
__device__ __forceinline__ float wave_sum(float v) {
#pragma unroll
    for (int o = 1; o < 64; o <<= 1) v += __shfl_xor(v, o);
    return v;
}
__device__ __forceinline__ float wave_max(float v) {
#pragma unroll
    for (int o = 1; o < 64; o <<= 1) v = fmaxf(v, __shfl_xor(v, o));
    return v;
}
__device__ __forceinline__ int lane_fresh() { int l; asm volatile("v_mbcnt_lo_u32_b32 %0, -1, 0\n\tv_mbcnt_hi_u32_b32 %0, -1, %0" : "=v"(l)); return l; }
__device__ __forceinline__ int t5_bucket(int rel) {
    const int ret = rel > 0 ? 16 : 0; const int n = rel < 0 ? -rel : rel;
    if (n < 8) return ret + n;
    int lg = 31 - __builtin_clz((unsigned)(n * n)) - 6;
    lg = lg > 7 ? 7 : lg;
    return ret + 8 + lg;
}

struct Args {
    const float* in[18]; float* out; unsigned char* ws; int ph_lo, ph_hi, li, pad;
};
typedef const __attribute__((address_space(4))) Args* KArgs;
__device__ __forceinline__ KArgs kargs() { KArgs p = (KArgs)__builtin_amdgcn_kernarg_segment_ptr(); asm volatile("" : "+s"(p)); return p; }
enum { I_X = 0, I_C, I_RELB, I_WADA, I_BADA, I_NMG, I_NFG, I_WIN, I_WF, I_BF, I_QG, I_KG, I_SINK, I_WOUT, I_WR, I_WG, I_WU, I_WD };

constexpr int NWAVES = 8, NTHR = 512;
constexpr int LDS_BYTES = 155648;

typedef float f32x16m __attribute__((ext_vector_type(16)));
__device__ __forceinline__ void p0_mod(KArgs a, LAS unsigned char* lds, int tid, int G) {
    const float* c = a->in[I_C]; const float* w_ada = a->in[I_WADA]; const float* b_ada = a->in[I_BADA];
    float* MOD = (float*)(a->ws + WS_MOD);
    const int wave = tid >> 6, lane = tid & 63, i = lane & 31, kk = lane >> 5;
    LAS float* part = (LAS float*)lds;
    for (int cb = blockIdx.x; cb < NADA / 32; cb += G) {
        const int k0 = wave * 128 + 4 * kk;
        f32x4 ca[16]; float wv[16][4];
#pragma unroll
        for (int q = 0; q < 16; ++q) ca[q] = *(const f32x4*)(c + i * DM + k0 + 8 * q);
#pragma unroll
        for (int q = 0; q < 16; ++q)
#pragma unroll
            for (int t = 0; t < 4; ++t) wv[q][t] = __builtin_nontemporal_load(w_ada + (size_t)(k0 + 8 * q + t) * NADA + cb * 32 + i);
        f32x16m acc;
#pragma unroll
        for (int r = 0; r < 16; ++r) acc[r] = 0.f;
#pragma unroll
        for (int q = 0; q < 16; ++q)
#pragma unroll
            for (int t = 0; t < 4; ++t) { const float x = ca[q][t]; acc = __builtin_amdgcn_mfma_f32_32x32x2f32(x * __builtin_amdgcn_rcpf(1.f + __builtin_amdgcn_exp2f(-LOG2E * x)), wv[q][t], acc, 0, 0, 0); }
#pragma unroll
        for (int r = 0; r < 16; ++r) part[(wave * 32 + (r & 3) + 8 * (r >> 2) + 4 * kk) * 32 + i] = acc[r];
        __syncthreads();
        for (int o = tid; o < 1024; o += NTHR) { const int bb = o >> 5, jj = o & 31; float sm = b_ada[cb * 32 + jj];
#pragma unroll
            for (int p = 0; p < 8; ++p) sm += part[(p * 32 + bb) * 32 + jj];
            MOD[bb * NADA + cb * 32 + jj] = sm; }
        __syncthreads();
    }
}
__device__ __forceinline__ void p0_transpose_item(const float* W, int N, bf16* WT, int ldk, int koff, int drow0, int hi_off, LAS float* scr, int k0, int n0, int lane) {
    f32x4 v[16];
#pragma unroll
    for (int i = 0; i < 16; ++i) v[i] = __builtin_nontemporal_load((const f32x4*)(W + (size_t)(k0 + 4 * i + (lane >> 4)) * N + n0 + 4 * (lane & 15)));
#pragma unroll
    for (int i = 0; i < 16; ++i) { const int kk = 4 * i + (lane >> 4); *(LAS f32x4*)(scr + kk * 64 + 4 * ((lane & 15) ^ (kk >> 3))) = v[i]; }
    asm volatile("s_waitcnt lgkmcnt(0)" ::: "memory");
    const int c = lane & 7;
#pragma unroll
    for (int j = 0; j < 8; ++j) { const int n = (lane >> 3) + 8 * j; float e[8];
#pragma unroll
        for (int t = 0; t < 8; ++t) e[t] = scr[(8 * c + t) * 64 + 4 * ((n >> 2) ^ c) + (n & 3)];
        v4u o; o.x = pk2(e[0], e[1]); o.y = pk2(e[2], e[3]); o.z = pk2(e[4], e[5]); o.w = pk2(e[6], e[7]);
        *(v4u*)(WT + (size_t)(drow0 + (n & 31) + hi_off * (n >> 5)) * ldk + koff + k0 + 8 * c) = o; }
    asm volatile("s_waitcnt lgkmcnt(0)" ::: "memory");
}
__device__ __forceinline__ void p0_transpose_item_fp8(const float* W, int N, unsigned char* WT, int drow0, LAS float* scr, int k0, int n0, int lane) {
    f32x4 v[16];
#pragma unroll
    for (int i = 0; i < 16; ++i) v[i] = __builtin_nontemporal_load((const f32x4*)(W + (size_t)(k0 + 4 * i + (lane >> 4)) * N + n0 + 4 * (lane & 15)));
#pragma unroll
    for (int i = 0; i < 16; ++i) { const int kk = 4 * i + (lane >> 4); *(LAS f32x4*)(scr + kk * 64 + 4 * ((lane & 15) ^ (kk >> 3))) = v[i]; }
    asm volatile("s_waitcnt lgkmcnt(0)" ::: "memory");
    const int n = lane;
#pragma unroll
    for (int c = 0; c < 8; c += 2) { float e[16];
#pragma unroll
        for (int t = 0; t < 16; ++t) { const int k = 8 * c + t; e[t] = scr[k * 64 + 4 * ((n >> 2) ^ (k >> 3)) + (n & 3)] * W8S; }
        v4u o; o.x = pk4_fp8(e[0], e[1], e[2], e[3]); o.y = pk4_fp8(e[4], e[5], e[6], e[7]); o.z = pk4_fp8(e[8], e[9], e[10], e[11]); o.w = pk4_fp8(e[12], e[13], e[14], e[15]);
        *(v4u*)(WT + (size_t)(drow0 + n) * 1024 + k0 + 8 * c) = o; }
    asm volatile("s_waitcnt lgkmcnt(0)" ::: "memory");
}
__device__ __forceinline__ void p0_maps(KArgs a, LAS unsigned char* lds, int tid, int G) {
    LAS float* wf = (LAS float*)lds;
    LAS float* ct = wf + 4096;
    LAS float* st = ct + 64;
    bf16* MAT = (bf16*)(a->ws + WS_MAT); bf16* MBT = (bf16*)(a->ws + WS_MBT);
    const float* w_f = a->in[I_WF];
    const float scale = 0.0027621358640099515f;
    const int first = (G >= NADA / 32 + 8) ? NADA / 32 : 0;
    for (int g = (int)blockIdx.x - first; g >= 0 && g < 8; g += G) {
        for (int i = tid; i < 4096; i += NTHR) wf[i] = w_f[g * 4096 + i];
        if (tid < 64) { ct[tid] = cospif((float)tid / 32.f); st[tid] = sinpif((float)tid / 32.f); }
        __syncthreads();
        for (int o = tid; o < 4096; o += NTHR) { const int d = o >> 6, c = o & 63; float sc = 0.f, ss = 0.f;
            for (int m = 0; m < 64; ++m) { const float w = wf[m * 64 + d]; const int ph = (m * c) & 63; sc += ct[ph] * w; ss += st[ph] * w; }
            MAT[g * 4096 + o] = (bf16)f2bf(sc * scale); MBT[g * 4096 + o] = (bf16)f2bf(-ss * scale); }
        __syncthreads();
    }
}
__device__ __forceinline__ void p0_rest(KArgs a, LAS unsigned char* lds, int tid, int wave, int lane, int vcu, int G) {
    LAS float* scr = (LAS float*)(lds + wave * 16384);
    const int gw = vcu * NWAVES + wave, NGW = G * NWAVES;
    bf16* WIN_T = (bf16*)(a->ws + WS_WIN); bf16* WOUT_T = (bf16*)(a->ws + WS_WOUT); unsigned char* WGU = a->ws + WS_WGU; unsigned char* WD = a->ws + WS_WD;
    constexpr int I_A = 16 * 20, I_B = 16 * 16, I_E = 16 * 16;
    constexpr int NITEMS = I_A + I_B + 16 * 3 * I_E, NTOT = NITEMS + 2048;
    bf16* T = (bf16*)(a->ws + WS_T);
    const int nfree = (G > NADA / 32) ? (G - NADA / 32) * NWAVES : 0;
    auto process = [&](int it) {
        int r = it;
        if (r >= NITEMS) {
            r -= NITEMS;
#pragma unroll
            for (int i2 = 0; i2 < 2; ++i2) { const int s0 = i2 * 512 + lane * 8; float v[8];
#pragma unroll
                for (int j = 0; j < 8; ++j) { const int sp = s0 + j;
                    v[j] = (r < 1024) ? cospif((float)((r * sp) & 2047) / 1024.f) : sinpif((float)(((r - 1024) * sp) & 2047) / 1024.f); }
                v4u o; o.x = pk2(v[0], v[1]); o.y = pk2(v[2], v[3]); o.z = pk2(v[4], v[5]); o.w = pk2(v[6], v[7]);
                *(v4u*)(T + (size_t)r * 1024 + s0) = o; }
        } else if (r < I_A) { const int kb = r / 20, nb = r % 20, n0 = nb * 64;
            const int t = n0 >> 8, hh = (n0 & 255) >> 6, drow = 256 * t + 32 * hh, hi = 128;
            p0_transpose_item(a->in[I_WIN], NPROJ, WIN_T, DM, 0, drow, hi, scr, kb * 64, n0, lane);
        } else if (r < I_A + I_B) { r -= I_A; const int kb = r / 16, nb = r % 16; p0_transpose_item(a->in[I_WOUT], DM, WOUT_T, KOUT, 0, nb * 64, 32, scr, kb * 64, nb * 64, lane);
        } else { r -= I_A + I_B;
            const int e = r / (3 * I_E), r2 = r % (3 * I_E), which = r2 / I_E, r3 = r2 % I_E, kb = r3 / 16, nb = r3 % 16, n0 = nb * 64;
            if (which == 0) p0_transpose_item_fp8(a->in[I_WG] + (size_t)e * DM * DEXP, DEXP, WGU + (size_t)e * 2048 * 1024, 256 * (n0 >> 7) + (n0 & 127), scr, kb * 64, n0, lane);
            else if (which == 1) p0_transpose_item_fp8(a->in[I_WU] + (size_t)e * DM * DEXP, DEXP, WGU + (size_t)e * 2048 * 1024, 256 * (n0 >> 7) + 128 + (n0 & 127), scr, kb * 64, n0, lane);
            else p0_transpose_item_fp8(a->in[I_WD] + (size_t)e * DEXP * DM, DM, WD + (size_t)e * 1024 * 1024, n0, scr, kb * 64, n0, lane);
        }
    };
    if ((int)blockIdx.x >= NADA / 32) process(((int)blockIdx.x - NADA / 32) * NWAVES + wave);
    for (int it = nfree + gw; it < NTOT; it += NGW) process(it);
}

__device__ __forceinline__ void ld_row_f32(const float* p, int lane, f32x4 (&v)[4]) {
    v[0] = __builtin_nontemporal_load((const f32x4*)(p + 8 * lane)); v[1] = __builtin_nontemporal_load((const f32x4*)(p + 8 * lane + 4)); v[2] = __builtin_nontemporal_load((const f32x4*)(p + 512 + 8 * lane)); v[3] = __builtin_nontemporal_load((const f32x4*)(p + 512 + 8 * lane + 4)); }
__device__ __forceinline__ void ld_row_f32c(const float* p, int lane, f32x4 (&v)[4]) {
    v[0] = *(const f32x4*)(p + 8 * lane); v[1] = *(const f32x4*)(p + 8 * lane + 4); v[2] = *(const f32x4*)(p + 512 + 8 * lane); v[3] = *(const f32x4*)(p + 512 + 8 * lane + 4); }
__device__ __forceinline__ void ld_row_bf(const bf16* p, int lane, v4u (&d)[2]) { d[0] = __builtin_nontemporal_load((const v4u*)(p + 8 * lane)); d[1] = __builtin_nontemporal_load((const v4u*)(p + 512 + 8 * lane)); }
__device__ __forceinline__ void add_bf(f32x4 (&v)[4], const v4u (&d)[2]) {
#pragma unroll
    for (int h = 0; h < 2; ++h) { v[2 * h].x += bf2f(d[h].x & 0xffffu); v[2 * h].y += bf2f(d[h].x >> 16); v[2 * h].z += bf2f(d[h].y & 0xffffu); v[2 * h].w += bf2f(d[h].y >> 16);
        v[2 * h + 1].x += bf2f(d[h].z & 0xffffu); v[2 * h + 1].y += bf2f(d[h].z >> 16); v[2 * h + 1].z += bf2f(d[h].w & 0xffffu); v[2 * h + 1].w += bf2f(d[h].w >> 16); } }
__device__ __forceinline__ void st_row_bf(bf16* p, int lane, const f32x4 (&v)[4]) {
#pragma unroll
    for (int h = 0; h < 2; ++h) { v4u w; w.x = pk2(v[2 * h].x, v[2 * h].y); w.y = pk2(v[2 * h].z, v[2 * h].w); w.z = pk2(v[2 * h + 1].x, v[2 * h + 1].y); w.w = pk2(v[2 * h + 1].z, v[2 * h + 1].w); __builtin_nontemporal_store(w, (v4u*)(p + 512 * h + 8 * lane)); } }
__device__ __forceinline__ void st_row_bf_plain(bf16* p, int lane, const f32x4 (&v)[4]) {
#pragma unroll
    for (int h = 0; h < 2; ++h) { v4u w; w.x = pk2(v[2 * h].x, v[2 * h].y); w.y = pk2(v[2 * h].z, v[2 * h].w); w.z = pk2(v[2 * h + 1].x, v[2 * h + 1].y); w.w = pk2(v[2 * h + 1].z, v[2 * h + 1].w); *(v4u*)(p + 512 * h + 8 * lane) = w; } }
__device__ __forceinline__ void ld_row_fp8(const unsigned char* p, int lane, v2u (&d)[2]) { d[0] = __builtin_nontemporal_load((const v2u*)(p + 8 * lane)); d[1] = __builtin_nontemporal_load((const v2u*)(p + 512 + 8 * lane)); }
__device__ __forceinline__ void add_fp8(f32x4 (&v)[4], const v2u (&d)[2]) {
    typedef float f2 __attribute__((ext_vector_type(2)));
#pragma unroll
    for (int h = 0; h < 2; ++h) { const f2 a = __builtin_amdgcn_cvt_pk_f32_fp8((int)d[h].x, false), b = __builtin_amdgcn_cvt_pk_f32_fp8((int)d[h].x, true), c = __builtin_amdgcn_cvt_pk_f32_fp8((int)d[h].y, false), e = __builtin_amdgcn_cvt_pk_f32_fp8((int)d[h].y, true);
        v[2 * h].x += a.x; v[2 * h].y += a.y; v[2 * h].z += b.x; v[2 * h].w += b.y; v[2 * h + 1].x += c.x; v[2 * h + 1].y += c.y; v[2 * h + 1].z += e.x; v[2 * h + 1].w += e.y; } }
__device__ __forceinline__ void st_row_fp8(unsigned char* p, int lane, const f32x4 (&v)[4]) {
#pragma unroll
    for (int h = 0; h < 2; ++h) { v2u w; w.x = pk4_fp8(v[2 * h].x, v[2 * h].y, v[2 * h].z, v[2 * h].w); w.y = pk4_fp8(v[2 * h + 1].x, v[2 * h + 1].y, v[2 * h + 1].z, v[2 * h + 1].w); *(v2u*)(p + 512 * h + 8 * lane) = w; } }
__device__ __forceinline__ float ssq4(const f32x4 (&v)[4]) { float s = 0.f;
#pragma unroll
    for (int j = 0; j < 4; ++j) s += (v[j].x * v[j].x + v[j].y * v[j].y) + (v[j].z * v[j].z + v[j].w * v[j].w);
    return s; }

__device__ __forceinline__ size_t h_row(int tok) { const int b = tok >> 11, s_ = tok & 2047; int t, r;
    if (s_ < 1024) { t = s_ >> 7; r = s_ & 127; } else if (s_ == 1024) { t = 0; r = 128; } else { const int sp = SEQ - s_; t = sp >> 7; r = 128 + (sp & 127); }
    return (size_t)(b * 8 + t) * 256 + r; }
__device__ __forceinline__ void p1_pair(const f32x4 (&va)[4], const f32x4 (&vb)[4], const f32x4 (&gs)[4], const f32x4 (&sh)[4], bf16* ha, bf16* hb, int lane) {
    float s0 = ssq4(va), s1 = ssq4(vb);
#pragma unroll
    for (int o = 1; o < 64; o <<= 1) { s0 += __shfl_xor(s0, o); s1 += __shfl_xor(s1, o); }
    const float r0 = 1.f / sqrtf(s0 * (1.f / DM) + EPS), r1 = 1.f / sqrtf(s1 * (1.f / DM) + EPS);
    f32x4 o[4];
#pragma unroll
    for (int j = 0; j < 4; ++j) o[j] = va[j] * r0 * gs[j] + sh[j];
    st_row_bf_plain(ha, lane, o);
#pragma unroll
    for (int j = 0; j < 4; ++j) o[j] = vb[j] * r1 * gs[j] + sh[j];
    st_row_bf_plain(hb, lane, o);
}
__device__ __forceinline__ void p1_h(KArgs a, int wave, int lane, int vcu, int G) {
    const int gw = vcu * NWAVES + wave, NGW = G * NWAVES;
    const float* MOD = (const float*)(a->ws + WS_MOD); const float* g = a->in[I_NMG]; const float* x = a->in[I_X]; bf16* H = (bf16*)(a->ws + WS_H);
    f32x4 gg[4]; ld_row_f32c(g, lane, gg);
    const int nst = MTOK / 4 / NGW;
    f32x4 a0[4], a1[4], b0[4], b1[4];
    { const float* xr = x + (size_t)(4 * gw) * DM; ld_row_f32(xr, lane, a0); ld_row_f32(xr + DM, lane, a1); }
    for (int it = 0; it < nst; ++it) {
        const int row0 = 4 * (it * NGW + gw), b = row0 / SEQ;
        const float* xr = x + (size_t)row0 * DM;
        ld_row_f32(xr + 2 * DM, lane, b0); ld_row_f32(xr + 3 * DM, lane, b1);
        f32x4 gs[4], sh[4];
        { f32x4 sc[4]; ld_row_f32c(MOD + b * NADA + DM, lane, sc); ld_row_f32c(MOD + b * NADA, lane, sh);
#pragma unroll
          for (int j = 0; j < 4; ++j) gs[j] = gg[j] * (sc[j] + 1.f); }
        p1_pair(a0, a1, gs, sh, H + h_row(row0) * DM, H + h_row(row0 + 1) * DM, lane);
        if (it + 1 < nst) { const float* xn = x + (size_t)(4 * ((it + 1) * NGW + gw)) * DM; ld_row_f32(xn, lane, a0); ld_row_f32(xn + DM, lane, a1); }
        p1_pair(b0, b1, gs, sh, H + h_row(row0 + 2) * DM, H + h_row(row0 + 3) * DM, lane);
    }
}

__device__ __forceinline__ float bfly16(const float (&t)[16], int lane) {
    const bool b5 = lane & 32, b4 = lane & 16, b3 = lane & 8, b2 = lane & 4;
    float u8[8], u4[4], u2[2], u1;
#pragma unroll
    for (int i = 0; i < 8; ++i) { const float send = b5 ? t[i] : t[i + 8], keep = b5 ? t[i + 8] : t[i]; u8[i] = keep + __shfl_xor(send, 32); }
#pragma unroll
    for (int i = 0; i < 4; ++i) { const float send = b4 ? u8[i] : u8[i + 4], keep = b4 ? u8[i + 4] : u8[i]; u4[i] = keep + __shfl_xor(send, 16); }
#pragma unroll
    for (int i = 0; i < 2; ++i) { const float send = b3 ? u4[i] : u4[i + 2], keep = b3 ? u4[i + 2] : u4[i]; u2[i] = keep + __shfl_xor(send, 8); }
    { const float send = b2 ? u2[0] : u2[1], keep = b2 ? u2[1] : u2[0]; u1 = keep + __shfl_xor(send, 4); }
    u1 += __shfl_xor(u1, 2); u1 += __shfl_xor(u1, 1);
    return u1;
}
__device__ __forceinline__ void dot16(const f32x4 (&v)[4], const LAS float* wr, int lane, float (&t)[16]) {
#pragma unroll
    for (int e = 0; e < 16; ++e) { float t0 = 0.f;
#pragma unroll
        for (int j = 0; j < 4; ++j) { const f32x4 w4 = *(const LAS f32x4*)(wr + e * 1024 + 256 * j + 4 * lane); t0 += (v[j].x * w4.x + v[j].y * w4.y) + (v[j].z * w4.z + v[j].w * w4.w); }
        t[e] = t0; asm volatile("" ::: "memory"); }
}
__device__ __forceinline__ void dot16x2(const f32x4 (&v0)[4], const f32x4 (&v1)[4], const LAS float* wr, int lane, float (&t0)[16], float (&t1)[16]) {
#pragma unroll
    for (int e = 0; e < 16; ++e) { f32x4 a0 = {0.f, 0.f, 0.f, 0.f}, a1 = a0;
#pragma unroll
        for (int j = 0; j < 4; ++j) { const f32x4 w4 = *(const LAS f32x4*)(wr + e * 1024 + 256 * j + 4 * lane); a0 += v0[j] * w4; a1 += v1[j] * w4; }
        t0[e] = (a0.x + a0.y) + (a0.z + a0.w); t1[e] = (a1.x + a1.y) + (a1.z + a1.w); asm volatile("" ::: "memory"); }
}
__device__ __forceinline__ void p5_router(KArgs a, LAS unsigned char* lds, int tid, int wave, int lane, int vcu, int G) {
    LAS float* wr = (LAS float*)lds;
    const float* w_router = a->in[I_WR];
    for (int i = tid; i < DM * NEXP; i += NTHR) { const int k = i >> 4, e = i & 15;
        wr[e * 1024 + 256 * (2 * (k >> 9) + ((k >> 2) & 1)) + 4 * ((k >> 3) & 63) + (k & 3)] = w_router[i]; }
    __syncthreads();
    const int gw = vcu * NWAVES + wave, NGW = G * NWAVES;
    const float* MOD = (const float*)(a->ws + WS_MOD); const float* g = a->in[I_NFG]; const float* x = a->in[I_X]; const bf16* DELTA = (const bf16*)(a->ws + WS_DELTA);
    unsigned char* H2 = a->ws + WS_H2; float* AFF = (float*)(a->ws + WS_AFF);
    for (int blk = gw; blk < MTOK / 32; blk += NGW) {
        const int row0 = blk * 32, b = row0 / SEQ;
        f32x4 gs[4], sh[4]; float ce;
        { f32x4 gg[4], sc[4]; ld_row_f32c(g, lane, gg); ld_row_f32c(MOD + b * NADA + 4 * DM, lane, sc); ld_row_f32c(MOD + b * NADA + 3 * DM, lane, sh);
#pragma unroll
          for (int j = 0; j < 4; ++j) gs[j] = gg[j] * (sc[j] + 1.f);
          float t[16]; dot16(sh, wr, lane, t); ce = bfly16(t, lane); }
        const float* xr = x + (size_t)row0 * DM; const bf16* dr = DELTA + (size_t)row0 * DM;
        f32x4 vn0[4], vn1[4]; v4u dn0[2], dn1[2];
        ld_row_f32(xr, lane, vn0); ld_row_bf(dr, lane, dn0); ld_row_f32(xr + DM, lane, vn1); ld_row_bf(dr + DM, lane, dn1);
        for (int r = 0; r < 32; r += 2) {
            f32x4 v0[4], v1[4];
#pragma unroll
            for (int j = 0; j < 4; ++j) { v0[j] = vn0[j]; v1[j] = vn1[j]; }
            add_bf(v0, dn0); add_bf(v1, dn1);
            st_row_bf((bf16*)dr + (size_t)r * DM, lane, v0); st_row_bf((bf16*)dr + (size_t)(r + 1) * DM, lane, v1);
            if (r + 2 < 32) { ld_row_f32(xr + (size_t)(r + 2) * DM, lane, vn0); ld_row_bf(dr + (size_t)(r + 2) * DM, lane, dn0); ld_row_f32(xr + (size_t)(r + 3) * DM, lane, vn1); ld_row_bf(dr + (size_t)(r + 3) * DM, lane, dn1); }
            float s0 = ssq4(v0), s1 = ssq4(v1);
#pragma unroll
            for (int j = 0; j < 4; ++j) { v0[j] = v0[j] * gs[j]; v1[j] = v1[j] * gs[j]; }
            float t0[16], t1[16]; dot16x2(v0, v1, wr, lane, t0, t1);
            float lg0 = bfly16(t0, lane), lg1 = bfly16(t1, lane);
#pragma unroll
            for (int o = 1; o < 64; o <<= 1) { s0 += __shfl_xor(s0, o); s1 += __shfl_xor(s1, o); }
            const float rs0 = 1.f / sqrtf(s0 * (1.f / DM) + EPS), rs1 = 1.f / sqrtf(s1 * (1.f / DM) + EPS);
#pragma unroll
            for (int j = 0; j < 4; ++j) { v0[j] = v0[j] * rs0 + sh[j]; v1[j] = v1[j] * rs1 + sh[j]; }
            st_row_fp8(H2 + (size_t)(row0 + r) * DM, lane, v0); st_row_fp8(H2 + (size_t)(row0 + r + 1) * DM, lane, v1);
            lg0 = lg0 * rs0 + ce; lg1 = lg1 * rs1 + ce;
            float mx0 = lg0, mx1 = lg1;
#pragma unroll
            for (int o = 4; o < 64; o <<= 1) { mx0 = fmaxf(mx0, __shfl_xor(mx0, o)); mx1 = fmaxf(mx1, __shfl_xor(mx1, o)); }
            const float p0 = expf(lg0 - mx0), p1 = expf(lg1 - mx1); float sum0 = p0, sum1 = p1;
#pragma unroll
            for (int o = 4; o < 64; o <<= 1) { sum0 += __shfl_xor(sum0, o); sum1 += __shfl_xor(sum1, o); }
            if ((lane & 3) == 0) { float* ap = AFF + ((size_t)b * NEXP + ((lane >> 2) & 15)) * SEQ + (row0 + r - b * SEQ); ap[0] = p0 / sum0; ap[1] = p1 / sum1; }
        }
    }
    __syncthreads();
}

__device__ __forceinline__ void p6_topk(KArgs a, LAS unsigned char* lds, int tid, int G) {
    LAS unsigned* hist = (LAS unsigned*)lds;
    LAS unsigned* sel = hist + 512;
    LAS unsigned* wtot = hist + 520;
    const float* AFF = (const float*)(a->ws + WS_AFF); int* IDX = (int*)(a->ws + WS_IDX); float* GATE = (float*)(a->ws + WS_GATE); int* INV = (int*)(a->ws + WS_INV);
    const int lane = tid & 63, wave = tid >> 6;
    for (int it0 = blockIdx.x; it0 < NPAIR; it0 += 2 * G) {
        const int itp[2] = {it0, it0 + G}; const bool has[2] = {true, it0 + G < NPAIR};
        unsigned key[2][4];
#pragma unroll
        for (int pr = 0; pr < 2; ++pr) { v4u kv = {0u, 0u, 0u, 0u}; if (has[pr]) kv = *(const v4u*)(AFF + (size_t)itp[pr] * SEQ + 4 * tid);
            key[pr][0] = kv.x; key[pr][1] = kv.y; key[pr][2] = kv.z; key[pr][3] = kv.w; }
        unsigned prefix[2] = {0u, 0u}, mask = 0u, krem[2] = {CAP, CAP};
#pragma unroll 1
        for (int shift = 24; shift >= 0; shift -= 8) {
            hist[tid] = 0u;
            __syncthreads();
#pragma unroll
            for (int pr = 0; pr < 2; ++pr) {
#pragma unroll
              for (int i = 0; i < 4; ++i) {
                const bool in = (key[pr][i] & mask) == prefix[pr]; const unsigned dg = (key[pr][i] >> shift) & 255u;
                unsigned long long todo = __ballot(in);
#pragma unroll 1
                for (int rnd = 0; rnd < (shift == 24 ? 4 : 0) && todo; ++rnd) { const int ld = __builtin_ctzll(todo); const unsigned d0 = (unsigned)__builtin_amdgcn_readlane((int)dg, ld);
                    const unsigned long long same = __ballot(in && dg == d0) & todo;
                    if (lane == ld) __hip_atomic_fetch_add(hist + pr * 256 + d0, (unsigned)__builtin_popcountll(same), __ATOMIC_RELAXED, __HIP_MEMORY_SCOPE_WORKGROUP);
                    todo &= ~same; }
                if ((todo >> lane) & 1ull) __hip_atomic_fetch_add(hist + pr * 256 + dg, 1u, __ATOMIC_RELAXED, __HIP_MEMORY_SCOPE_WORKGROUP);
              } }
            __syncthreads();
            if (wave < 2) {
                const int pr = wave; const unsigned kr = pr == 0 ? krem[0] : krem[1];
                const unsigned h0 = hist[pr * 256 + 4 * lane], h1 = hist[pr * 256 + 4 * lane + 1], h2 = hist[pr * 256 + 4 * lane + 2], h3 = hist[pr * 256 + 4 * lane + 3];
                const unsigned tot = h0 + h1 + h2 + h3; unsigned inc = tot;
#pragma unroll
                for (int o = 1; o < 64; o <<= 1) { const unsigned t = __shfl_down(inc, o); if (lane + o < 64) inc += t; }
                const unsigned above3 = inc - tot, above2 = above3 + h3, above1 = above2 + h2, above0 = above1 + h1;
                if (above3 < kr && kr <= above3 + h3) { sel[pr * 2] = 4 * lane + 3; sel[pr * 2 + 1] = kr - above3; }
                if (above2 < kr && kr <= above2 + h2) { sel[pr * 2] = 4 * lane + 2; sel[pr * 2 + 1] = kr - above2; }
                if (above1 < kr && kr <= above1 + h1) { sel[pr * 2] = 4 * lane + 1; sel[pr * 2 + 1] = kr - above1; }
                if (above0 < kr && kr <= above0 + h0) { sel[pr * 2] = 4 * lane;     sel[pr * 2 + 1] = kr - above0; }
            }
            __syncthreads();
#pragma unroll
            for (int pr = 0; pr < 2; ++pr) { prefix[pr] |= sel[pr * 2] << shift; krem[pr] = sel[pr * 2 + 1]; }
            mask |= 255u << shift;
        }
        unsigned pk[2], inc[2];
#pragma unroll
        for (int pr = 0; pr < 2; ++pr) { unsigned cg = 0, ce = 0;
#pragma unroll
            for (int i = 0; i < 4; ++i) { cg += key[pr][i] > prefix[pr]; ce += key[pr][i] == prefix[pr]; }
            pk[pr] = cg | (ce << 16); inc[pr] = pk[pr];
#pragma unroll
            for (int o = 1; o < 64; o <<= 1) { const unsigned t = __shfl_up(inc[pr], o); if (lane >= o) inc[pr] += t; }
            if (lane == 63) wtot[pr * 8 + wave] = inc[pr]; }
        __syncthreads();
#pragma unroll
        for (int pr = 0; pr < 2; ++pr) { if (!has[pr]) continue;
            const int it = itp[pr], b = it >> 4, e = it & 15;
            unsigned base = 0;
            for (int w = 0; w < wave; ++w) base += wtot[pr * 8 + w];
            unsigned excl = base + inc[pr] - pk[pr]; unsigned ng = excl & 0xffffu, ne = excl >> 16;
            const unsigned kr = krem[pr], pf = prefix[pr];
#pragma unroll
            for (int i = 0; i < 4; ++i) { const int s_ = 4 * tid + i; int slot = -1;
                if (key[pr][i] > pf) { slot = (int)(ng + (ne < kr ? ne : kr)); ++ng; }
                else if (key[pr][i] == pf) { if (ne < kr) slot = (int)(ng + ne); ++ne; }
                if (slot >= 0) { IDX[it * CAP + slot] = s_; GATE[it * CAP + slot] = __builtin_bit_cast(float, key[pr][i]); }
                INV[((size_t)b * SEQ + s_) * NEXP + e] = slot; } }
        __syncthreads();
    }
}

#define QDPP(x, ctl) __builtin_bit_cast(float, __builtin_amdgcn_update_dpp(0, __builtin_bit_cast(int, (float)(x)), ctl, 0xf, 0xf, false))
__device__ __forceinline__ f32x4 quad_sel_lo(const f32x4 a, const f32x4 b, int odd) {
    f32x4 r;
    { const float p = QDPP(a.x, 0x50), q = QDPP(b.x, 0x50); r.x = odd ? q : p; }
    { const float p = QDPP(a.y, 0x50), q = QDPP(b.y, 0x50); r.y = odd ? q : p; }
    { const float p = QDPP(a.z, 0x50), q = QDPP(b.z, 0x50); r.z = odd ? q : p; }
    { const float p = QDPP(a.w, 0x50), q = QDPP(b.w, 0x50); r.w = odd ? q : p; }
    return r; }
__device__ __forceinline__ f32x4 quad_sel_hi(const f32x4 a, const f32x4 b, int odd) {
    f32x4 r;
    { const float p = QDPP(a.x, 0xFA), q = QDPP(b.x, 0xFA); r.x = odd ? q : p; }
    { const float p = QDPP(a.y, 0xFA), q = QDPP(b.y, 0xFA); r.y = odd ? q : p; }
    { const float p = QDPP(a.z, 0xFA), q = QDPP(b.z, 0xFA); r.z = odd ? q : p; }
    { const float p = QDPP(a.w, 0xFA), q = QDPP(b.w, 0xFA); r.w = odd ? q : p; }
    return r; }
__device__ __forceinline__ f32x4 oct_mix(const f32x4 own, const f32x4 other, int ctl_shr, bool take_own) { f32x4 r;
    { const float q = ctl_shr ? QDPP(other.x, 0x114) : QDPP(other.x, 0x104); r.x = take_own ? own.x : q; }
    { const float q = ctl_shr ? QDPP(other.y, 0x114) : QDPP(other.y, 0x104); r.y = take_own ? own.y : q; }
    { const float q = ctl_shr ? QDPP(other.z, 0x114) : QDPP(other.z, 0x104); r.z = take_own ? own.z : q; }
    { const float q = ctl_shr ? QDPP(other.w, 0x114) : QDPP(other.w, 0x104); r.w = take_own ? own.w : q; }
    return r; }
__device__ __forceinline__ void st_row_f32_quad(float* prow, int lane, const f32x4 (&v)[4]) {
    const int odd = lane & 1; const bool evq = ((lane >> 2) & 1) == 0;
    float* ob = prow + 64 * (lane >> 3) + (evq ? 0 : 16) + 4 * (lane & 3);
#pragma unroll
    for (int h = 0; h < 2; ++h) {
        const f32x4 lo = quad_sel_lo(v[2 * h], v[2 * h + 1], odd), hi = quad_sel_hi(v[2 * h], v[2 * h + 1], odd);
        __builtin_nontemporal_store(oct_mix(lo, hi, 1, evq), (f32x4*)(ob + 512 * h));
        __builtin_nontemporal_store(oct_mix(hi, lo, 0, !evq), (f32x4*)(ob + 512 * h + 32)); }
}
__device__ __forceinline__ void fma_fp8(f32x4 (&v)[4], const v2u (&d)[2], const f32x4 (&g)[4]) {
    typedef float f2 __attribute__((ext_vector_type(2)));
#pragma unroll
    for (int h = 0; h < 2; ++h) { const f2 a = __builtin_amdgcn_cvt_pk_f32_fp8((int)d[h].x, false), b = __builtin_amdgcn_cvt_pk_f32_fp8((int)d[h].x, true), c = __builtin_amdgcn_cvt_pk_f32_fp8((int)d[h].y, false), e = __builtin_amdgcn_cvt_pk_f32_fp8((int)d[h].y, true);
        v[2 * h].x += g[2 * h].x * a.x; v[2 * h].y += g[2 * h].y * a.y; v[2 * h].z += g[2 * h].z * b.x; v[2 * h].w += g[2 * h].w * b.y;
        v[2 * h + 1].x += g[2 * h + 1].x * c.x; v[2 * h + 1].y += g[2 * h + 1].y * c.y; v[2 * h + 1].z += g[2 * h + 1].z * e.x; v[2 * h + 1].w += g[2 * h + 1].w * e.y; } }
#define P9_PICK(m, e) do { _Pragma("unroll") for (int t = 0; t < 4; ++t) _Pragma("unroll") for (int k = 0; k < 2; ++k) { e[t][k] = -1; if (m[t]) { e[t][k] = __builtin_ctz(m[t]); m[t] &= m[t] - 1; } } } while (0)
#define P9_ISSUE(e, y, inv, YBb) do { _Pragma("unroll") for (int t = 0; t < 4; ++t) _Pragma("unroll") for (int k = 0; k < 2; ++k) if (e[t][k] >= 0) { \
        const int c_ = __builtin_amdgcn_readlane(inv, 16 * t + e[t][k]); ld_row_fp8((YBb) + ((size_t)e[t][k] * CAP + c_) * DM, lane, y[t][k]); } } while (0)
#define P9_ACC(e, y, res, g2) do { _Pragma("unroll") for (int t = 0; t < 4; ++t) _Pragma("unroll") for (int k = 0; k < 2; ++k) if (e[t][k] >= 0) fma_fp8(res[t], y[t][k], g2); } while (0)
__device__ __forceinline__ void p9_combine(KArgs a, int lane, int qbeg, int nq, int gw, int NGW) {
    const float* MOD = (const float*)(a->ws + WS_MOD); const unsigned char* YB = a->ws + WS_YB;   const int* INV = (const int*)(a->ws + WS_INV); float* out = a->out;
    const bf16* X1 = (const bf16*)(a->ws + WS_DELTA);
    int q = qbeg + gw; const int qend = qbeg + nq;
    if (q >= qend) return;
    v4u d[4][2], n[4][2];
#pragma unroll
    for (int t = 0; t < 4; ++t) ld_row_bf(X1 + ((size_t)q * 4 + t) * DM, lane, d[t]);
    int inv = INV[(size_t)q * 4 * NEXP + lane];
    f32x4 res[4][4]; float* pout = nullptr;
    for (; q < qend; q += NGW) {
        const size_t r0 = (size_t)q * 4; const int b = (int)(r0 / SEQ);
        f32x4 g2[4]; ld_row_f32c(MOD + b * NADA + 5 * DM, lane, g2);
        const unsigned char* YBb = YB + (size_t)b * NEXP * CAP * DM;
        const int qn = q + NGW; const bool more = qn < qend;
        const int invn = more ? INV[(size_t)qn * 4 * NEXP + lane] : 0;
        if (more) {
#pragma unroll
            for (int t = 0; t < 4; ++t) ld_row_bf(X1 + ((size_t)qn * 4 + t) * DM, lane, n[t]); }
        const unsigned long long bal = __ballot(inv >= 0);
        unsigned m[4];
#pragma unroll
        for (int t = 0; t < 4; ++t) m[t] = (unsigned)(bal >> (16 * t)) & 0xffffu;
        int e[4][2]; v2u y[4][2][2];
        P9_PICK(m, e); P9_ISSUE(e, y, inv, YBb);
        if (pout) {
#pragma unroll
            for (int t = 0; t < 4; ++t) st_row_f32_quad(pout + (size_t)t * DM, lane, res[t]); }
#pragma unroll
        for (int j = 0; j < 4; ++j) g2[j] = g2[j] * W8I;
#pragma unroll
        for (int t = 0; t < 4; ++t) {
#pragma unroll
            for (int j = 0; j < 4; ++j) res[t][j] = (f32x4){0.f, 0.f, 0.f, 0.f};
            add_bf(res[t], d[t]); }
        P9_ACC(e, y, res, g2);
        while (m[0] | m[1] | m[2] | m[3]) { P9_PICK(m, e); P9_ISSUE(e, y, inv, YBb); P9_ACC(e, y, res, g2); }
        pout = out + r0 * DM;
        if (more) {
#pragma unroll
            for (int t = 0; t < 4; ++t) { d[t][0] = n[t][0]; d[t][1] = n[t][1]; } }
        inv = invn;
    }
#pragma unroll
    for (int t = 0; t < 4; ++t) st_row_f32_quad(pout + (size_t)t * DM, lane, res[t]);
}
#undef P9_PICK
#undef P9_ISSUE
#undef P9_ACC

#define XB_TMO      128
#define XB_XCNT(j)  (256  + 64 * (j))
#define XB_XSUB(j)  (1280 + 64 * (j))
#define XB_XGEN(j)  (2304 + 64 * (j))
#define XB_TOP      3328
#define XB_TOPGEN   3392
#define XCD_BAR_WORDS 3456
#define XB_SPIN_CAP (1u << 22)
__device__ __forceinline__ unsigned xb_ld(unsigned* p)              { return __hip_atomic_load(p, __ATOMIC_RELAXED, __HIP_MEMORY_SCOPE_AGENT); }
__device__ __forceinline__ unsigned xb_add(unsigned* p, unsigned v) { return __hip_atomic_fetch_add(p, v, __ATOMIC_RELAXED, __HIP_MEMORY_SCOPE_AGENT); }
__device__ __forceinline__ unsigned xb_xcc_id() { return (unsigned)__builtin_amdgcn_s_getreg((3 << 11) | 20) & 0xFu; }
#define XB_SPIN(cond, bar) do { unsigned _sp = 0; while (cond) { __builtin_amdgcn_s_sleep(1); \
    if ((++_sp & 255u) == 0u) { if (xb_ld(&(bar)[XB_TMO])) break; if (_sp > XB_SPIN_CAP) { atomicAdd(&(bar)[XB_TMO], 1u); break; } } } } while (0)
struct XcdBarrier { unsigned* bar; unsigned x; volatile LAS unsigned* st; };
__device__ __forceinline__ XcdBarrier xcd_barrier_post(unsigned* bar, volatile LAS unsigned* st, int wave) {
    XcdBarrier b; b.bar = bar; b.x = xb_xcc_id(); b.st = st;
    if (wave == 0 && lane_fresh() == 0) (void)xb_add(&bar[XB_XCNT(b.x)], 1u);
    return b;
}
__device__ __forceinline__ void xcd_barrier_complete(unsigned* bar, unsigned x, unsigned& nloc, unsigned& nx) {
    const unsigned G = gridDim.x * gridDim.y * gridDim.z;
    unsigned sum, cnt, mine, sp = 0u;
    for (;;) {
        sum = 0u; cnt = 0u; mine = 0u;
#pragma unroll
        for (unsigned j = 0; j < 16; ++j) { const unsigned c = xb_ld(&bar[XB_XCNT(j)]); sum += c; cnt += (c > 0u) ? 1u : 0u; mine = (j == x) ? c : mine; }
        if (sum == G) break;
        __builtin_amdgcn_s_sleep(1);
        if ((++sp & 255u) == 0u) { if (xb_ld(&bar[XB_TMO])) break; if (sp > XB_SPIN_CAP) { atomicAdd(&bar[XB_TMO], 1u); break; } }
    }
    nloc = mine > 0u ? mine : 1u; nx = cnt > 0u ? cnt : 1u;
}
__device__ __forceinline__ void xcd_barrier(const XcdBarrier& b, int wave) {
    asm volatile("s_waitcnt vmcnt(0)" ::: "memory");
    __syncthreads();
    if (wave == 0 && lane_fresh() == 0) {
        unsigned* bar = b.bar;
        __builtin_amdgcn_s_waitcnt(0);
        unsigned nloc = b.st[0], nx = b.st[1];
        if (nloc == 0u) { xcd_barrier_complete(bar, b.x, nloc, nx); b.st[0] = nloc; b.st[1] = nx; }
        const unsigned old = xb_add(&bar[XB_XSUB(b.x)], 1u);
        const unsigned gen = old / nloc;
        if (old + 1u == (gen + 1u) * nloc) {
            __builtin_amdgcn_fence(__ATOMIC_RELEASE, "agent");
            asm volatile("s_waitcnt vmcnt(0)" ::: "memory");
            const unsigned og = xb_add(&bar[XB_TOP], 1u);
            const unsigned tg = og / nx;
            if (og + 1u == (tg + 1u) * nx) xb_add(&bar[XB_TOPGEN], 1u);
            else XB_SPIN(xb_ld(&bar[XB_TOPGEN]) == tg, bar);
            __builtin_amdgcn_fence(__ATOMIC_ACQUIRE, "agent");
            xb_add(&bar[XB_XGEN(b.x)], 1u);
            asm volatile("s_waitcnt vmcnt(0)" ::: "memory");
        } else {
            XB_SPIN(xb_ld(&bar[XB_XGEN(b.x)]) == gen, bar);
            __builtin_amdgcn_fence(__ATOMIC_ACQUIRE, "agent");
            asm volatile("s_waitcnt vmcnt(0)" ::: "memory");
        }
    }
    __syncthreads();
}

#ifndef PG8_ALIGN_EPI
#define PG8_ALIGN_EPI 1
#endif
namespace pg8 {
constexpr int BM = 256, BK = 64, HALF = 128, HTB = HALF * BK * 2, STAGE_BYTES = 8 * HTB, NXCD = 8, WGM = 8;
constexpr int UTAB_OFF = 147456 + 1024, MAXU = 24;
__host__ __device__ __forceinline__ int lds_byte(int r, int c) { const int st = (r >> 4) * 2 + (c >> 5), rr = r & 15, cc = c & 31, ob = rr * 64 + cc * 2; return st * 1024 + (ob ^ (((ob >> 9) & 1) << 5)); }
__host__ __device__ __forceinline__ void stage_rc(int b, int& R, int& C) { const int st = b / 1024, sb = b % 1024, swz = sb ^ (((sb >> 9) & 1) << 5); R = (st >> 1) * 16 + swz / 64; C = (st & 1) * 32 + (swz % 64) / 2; }
__host__ __device__ __forceinline__ int perm32(int rho) { const int n = rho >> 4, i = rho & 15; return 8 * (i >> 2) + 4 * n + (i & 3); }
typedef int v8i __attribute__((ext_vector_type(8))); typedef int v4i __attribute__((ext_vector_type(4)));
__device__ __forceinline__ v8i cat8(bf16x8 lo, bf16x8 hi) { return __builtin_shufflevector(__builtin_bit_cast(v4i, lo), __builtin_bit_cast(v4i, hi), 0, 1, 2, 3, 4, 5, 6, 7); }
struct Unit { int pm, pn; };
struct StaticOrder {
    int nM, nN, nwg, G, c;
    __device__ void init(int M, int N, int G_, int c_) { nM = M / BM; nN = N / BM; nwg = nM * nN; G = G_; c = c_; }
    __device__ bool next(int i, Unit& u) const {
        const long L = (long)i * G + c; if (L >= nwg) return false;
        int wgid = (int)L; { const int q = nwg / NXCD, r = nwg % NXCD, xcd = wgid % NXCD, off = wgid / NXCD; wgid = (xcd < r ? xcd * (q + 1) : r * (q + 1) + (xcd - r) * q) + off; }
        const int nig = WGM * nN, gid = wgid / nig, fm = gid * WGM, gsz = (nM - fm) < WGM ? (nM - fm) : WGM;
        u.pm = fm + ((wgid % nig) % gsz); u.pn = (wgid % nig) / gsz; return true;
    }
};
template <class Epi, class Prob>
__device__ __forceinline__ void gemm_phase(LAS unsigned char* lds, const Prob& P, const Epi& E, const int wid) {
    const int lane = lane_fresh(), tid = wid * 64 + lane, wr = wid >> 2, wc = wid & 3, fr = lane & 15, fq = lane >> 4;
    constexpr bool F8 = Prob::FP8;
    constexpr int KB = F8 ? 1024 : 2048, nt = KB / 128;
    constexpr bool GA = Prob::GATHER; constexpr bool B16 = Prob::B16;
    constexpr size_t rstepB = (size_t)(B16 ? 128 : 64) * KB, hstepB = (size_t)(B16 ? 8 : HALF) * KB;
    unsigned voB, voA; int gR0; unsigned gC2; const size_t rstep64 = (size_t)64 * KB;
    { int R0, C0; stage_rc(tid * 16, R0, C0); voA = (unsigned)(R0 * KB + C0 * 2); gR0 = R0; gC2 = (unsigned)C0 * 2u;
      const int Rb0 = B16 ? 64 * (R0 >> 5) + 16 * ((R0 & 15) >> 2) + 4 * ((R0 >> 4) & 1) + (R0 & 3) : (R0 & ~31) + perm32(R0 & 31); voB = (unsigned)(Rb0 * KB + C0 * 2); }
    const size_t kstep = (size_t)(BK * 2), hstep = (size_t)HALF * KB;
    const unsigned ldsw = (unsigned)wid * 1024u;
    const int aoff = lds_byte(wr * 64 + fr, fq * 8), boff = lds_byte(wc * 32 + fr, fq * 8);
#define PG8_SA(b, h) (((b) * 2 + (h)) * HTB)
#define PG8_SB(b, h) ((4 + (b) * 2 + (h)) * HTB)
#define PG8_STAGE2(bufoff, gbase, vo0, vo1) do { \
        __builtin_amdgcn_global_load_lds((const unsigned*)((const char*)(gbase) + (vo0)), (LAS unsigned*)(lds + (bufoff) + ldsw), 16, 0, 0); \
        __builtin_amdgcn_global_load_lds((const unsigned*)((const char*)(gbase) + (vo1)), (LAS unsigned*)(lds + (bufoff) + ldsw + 8192), 16, 0, 0); } while (0)
#define PG8_STAGE(bufoff, gbase, vo) do { \
        __builtin_amdgcn_global_load_lds((const unsigned*)((const char*)(gbase) + (vo)), (LAS unsigned*)(lds + (bufoff) + ldsw), 16, 0, 0); \
        __builtin_amdgcn_global_load_lds((const unsigned*)((const char*)(gbase) + rstep64 + (vo)), (LAS unsigned*)(lds + (bufoff) + ldsw + 8192), 16, 0, 0); } while (0)
#define PG8_STAGEB(bufoff, gbase) do { \
        __builtin_amdgcn_global_load_lds((const unsigned*)((const char*)(gbase) + (voB)), (LAS unsigned*)(lds + (bufoff) + ldsw), 16, 0, 0); \
        __builtin_amdgcn_global_load_lds((const unsigned*)((const char*)(gbase) + rstepB + (voB)), (LAS unsigned*)(lds + (bufoff) + ldsw + 8192), 16, 0, 0); } while (0)
#define PG8_GOFF(UIX, h) do { if constexpr (GA) { const LAS unsigned* _gp = P.goff + (UIX) * 256 + (h) * 128 + gR0; go0 = _gp[0]; go1 = _gp[64]; } } while (0)
#define PG8_STAGE_A(bufoff, gbase, UIX, h) do { if constexpr (GA) { const unsigned _v0 = go0 + gC2, _v1 = go1 + gC2; PG8_STAGE2(bufoff, gbase, _v0, _v1); } \
        else { PG8_STAGE(bufoff, (gbase) + (size_t)(h) * hstep, voA); } } while (0)
#define PG8_LDA(dst, b, h) do { _Pragma("unroll") for (int m = 0; m < 4; ++m) { const bf16x8 lo_ = *(const LAS bf16x8*)(lds + PG8_SA(b, h) + aoff + m * 2048), hi_ = *(const LAS bf16x8*)(lds + PG8_SA(b, h) + aoff + m * 2048 + 1024); \
        if constexpr (F8) dst##8[m] = cat8(lo_, hi_); else { dst[m][0] = lo_; dst[m][1] = hi_; } } } while (0)
#define PG8_LDB(dst, b, h) do { _Pragma("unroll") for (int n = 0; n < 2; ++n) { const bf16x8 lo_ = *(const LAS bf16x8*)(lds + PG8_SB(b, h) + boff + n * 2048), hi_ = *(const LAS bf16x8*)(lds + PG8_SB(b, h) + boff + n * 2048 + 1024); \
        if constexpr (F8) dst##8[n] = cat8(lo_, hi_); else { dst[n][0] = lo_; dst[n][1] = hi_; } } } while (0)
#define PG8_MMA(ai, bj, At, Bt) do { __builtin_amdgcn_s_setprio(1); _Pragma("unroll") for (int m = 0; m < 4; ++m) _Pragma("unroll") for (int n = 0; n < 2; ++n) { \
        if constexpr (F8) asm volatile("v_mfma_f32_16x16x128_f8f6f4 %0, %1, %2, %0" : "+v"(acc[ai][bj][m][n]) : "v"(Bt##8[n]), "v"(At##8[m])); \
        else { _Pragma("unroll") for (int k = 0; k < 2; ++k) acc[ai][bj][m][n] = __builtin_amdgcn_mfma_f32_16x16x32_bf16(Bt[n][k], At[m][k], acc[ai][bj][m][n], 0, 0, 0); } } \
        __builtin_amdgcn_s_setprio(0); } while (0)
#define PG8_MMA0(ai, bj, At, Bt) do { __builtin_amdgcn_s_setprio(1); _Pragma("unroll") for (int m = 0; m < 4; ++m) _Pragma("unroll") for (int n = 0; n < 2; ++n) { \
        if constexpr (F8) asm volatile("v_mfma_f32_16x16x128_f8f6f4 %0, %1, %2, 0" : "=&v"(acc[ai][bj][m][n]) : "v"(Bt##8[n]), "v"(At##8[m])); \
        else { acc[ai][bj][m][n] = __builtin_amdgcn_mfma_f32_16x16x32_bf16(Bt[n][0], At[m][0], (f32x4){0.f, 0.f, 0.f, 0.f}, 0, 0, 0); \
               acc[ai][bj][m][n] = __builtin_amdgcn_mfma_f32_16x16x32_bf16(Bt[n][1], At[m][1], acc[ai][bj][m][n], 0, 0, 0); } } \
        __builtin_amdgcn_s_setprio(0); } while (0)
#define PG8_WAIT_V(n) asm volatile("s_waitcnt vmcnt(" #n ")" ::: "memory")
#define PG8_WAIT_L(n) asm volatile("s_waitcnt lgkmcnt(" #n ")" ::: "memory")
#define PG8_BAR __builtin_amdgcn_s_barrier()
#define PG8_SCHED __builtin_amdgcn_sched_barrier(0)
#define PG8_BODYM(VA1, VAX, MM) do { \
            PG8_GOFF(VA1, 1); PG8_LDB(B0, 0, 0); PG8_LDB(B1, 0, 1); PG8_SCHED; PG8_LDA(At, 0, 0); PG8_STAGE_A(PG8_SA(1, 1), a1, VA1, 1); \
            PG8_WAIT_V(8); PG8_WAIT_L(0); PG8_BAR; MM(0, 0, At, B0); MM(0, 1, At, B1); PG8_BAR; PG8_SCHED; \
            PG8_GOFF(VAX, 0); PG8_LDA(At, 0, 1); PG8_STAGEB(PG8_SB(0, 0), b2); PG8_STAGEB(PG8_SB(0, 1), b2 + hstepB); PG8_STAGE_A(PG8_SA(0, 0), a2, VAX, 0); \
            PG8_WAIT_V(8); PG8_WAIT_L(0); PG8_BAR; MM(1, 0, At, B0); MM(1, 1, At, B1); PG8_BAR; PG8_SCHED; \
            PG8_GOFF(VAX, 1); PG8_LDB(B0, 1, 0); PG8_LDB(B1, 1, 1); PG8_SCHED; PG8_LDA(At, 1, 0); PG8_STAGE_A(PG8_SA(0, 1), a2, VAX, 1); \
            PG8_WAIT_V(8); PG8_WAIT_L(0); PG8_BAR; PG8_MMA(0, 0, At, B0); PG8_MMA(0, 1, At, B1); PG8_BAR; PG8_SCHED; \
            PG8_GOFF(VAX, 0); PG8_LDA(At, 1, 1); PG8_STAGEB(PG8_SB(1, 0), b3); PG8_STAGEB(PG8_SB(1, 1), b3 + hstepB); PG8_STAGE_A(PG8_SA(1, 0), a3, VAX, 0); \
            PG8_WAIT_V(8); PG8_WAIT_L(0); PG8_BAR; PG8_MMA(1, 0, At, B0); PG8_MMA(1, 1, At, B1); PG8_BAR; PG8_SCHED; } while (0)
#define PG8_BODY(VA1, VAX) PG8_BODYM(VA1, VAX, PG8_MMA)
    LAS int* utab = (LAS int*)(lds + UTAB_OFF);
    if (tid <= MAXU) { Unit t; const bool ok = (tid < MAXU) && P.next(tid, t); utab[tid] = ok ? (t.pm | (t.pn << 16)) : -1; }
    __syncthreads();
    Unit cur, nxt; nxt.pm = 0; nxt.pn = 0; int ui = 0;
    { const int e = __builtin_amdgcn_readfirstlane(utab[0]); if (e < 0) return; cur.pm = e & 0xffff; cur.pn = e >> 16; }
    f32x4 acc[2][2][4][2];
    if constexpr (!F8) {
#pragma unroll
    for (int a = 0; a < 2; ++a)
#pragma unroll
        for (int b = 0; b < 2; ++b)
#pragma unroll
            for (int m = 0; m < 4; ++m)
#pragma unroll
                for (int n = 0; n < 2; ++n) acc[a][b][m][n] = (f32x4){0.f, 0.f, 0.f, 0.f};
    }
    bf16x8 At[4][2], B0[2][2], B1[2][2]; v8i At8[4], B08[2], B18[2];
    const char* cA = P.a_base(cur); const char* cB = P.b_base(cur);
    unsigned go0 = 0u, go1 = 0u;
    PG8_STAGEB(PG8_SB(0, 0), cB); PG8_STAGEB(PG8_SB(0, 1), cB + hstepB); PG8_GOFF(0, 0); PG8_STAGE_A(PG8_SA(0, 0), cA, 0, 0); PG8_GOFF(0, 1); PG8_STAGE_A(PG8_SA(0, 1), cA, 0, 1);
    if (wr == 1) PG8_BAR;
    PG8_WAIT_V(2); PG8_BAR;
    PG8_STAGEB(PG8_SB(1, 0), cB + kstep); PG8_GOFF(0, 0); PG8_STAGE_A(PG8_SA(1, 0), cA + kstep, 0, 0); PG8_STAGEB(PG8_SB(1, 1), cB + hstepB + kstep);
    PG8_WAIT_V(6); PG8_BAR;
    for (;;) {
        const int en = __builtin_amdgcn_readfirstlane(utab[ui + 1]); const bool has_next = en >= 0; nxt.pm = en & 0xffff; nxt.pn = (en >> 16) & 0xffff;
        const char* nA = has_next ? P.a_base(nxt) : cA; const char* nB = has_next ? P.b_base(nxt) : cB;
        int ntr = nt - 2; asm volatile("" : "+s"(ntr));
        int t0 = 0;
        if constexpr (F8) { const char* a1 = cA + kstep; const char* a2 = cA + 2 * kstep; const char* b2 = cB + 2 * kstep; const char* a3 = a2 + kstep; const char* b3 = b2 + kstep;
          PG8_BODYM(ui, ui, PG8_MMA0); t0 = 2; }
#pragma nounroll
        for (int t = t0; t < ntr; t += 2) {
            const char* a1 = cA + (size_t)(t + 1) * kstep;
            const char* a2 = cA + (size_t)(t + 2) * kstep; const char* b2 = cB + (size_t)(t + 2) * kstep;
            const char* a3 = a2 + kstep; const char* b3 = b2 + kstep;
            PG8_BODY(ui, ui);
        }
        {
            const char* a1 = cA + (size_t)(nt - 1) * kstep;
            const char* a2 = nA; const char* b2 = nB; const char* a3 = a2 + kstep; const char* b3 = b2 + kstep;
            const int uin = has_next ? ui + 1 : ui;
            PG8_BODY(ui, uin);
        }
        if constexpr (F8) asm volatile("s_nop 15\n\ts_nop 15" ::: "memory");
        if (PG8_ALIGN_EPI) { if (wr == 0) PG8_BAR; }
        { const int le = lane_fresh(); E(acc, cur, wr, wc, le & 15, le >> 4, ui); }
        if (!has_next) break;
        if constexpr (!F8) {
#pragma unroll
        for (int a = 0; a < 2; ++a)
#pragma unroll
            for (int b = 0; b < 2; ++b)
#pragma unroll
                for (int m = 0; m < 4; ++m)
#pragma unroll
                    for (int n = 0; n < 2; ++n) acc[a][b][m][n] = (f32x4){0.f, 0.f, 0.f, 0.f};
        }
        cur = nxt; cA = nA; cB = nB; ++ui;
        if (PG8_ALIGN_EPI) { if (wr == 1) PG8_BAR; }
    }
    PG8_WAIT_V(0);
    if (!PG8_ALIGN_EPI) { if (wr == 0) PG8_BAR; }
    PG8_BAR;
#undef PG8_BODY
#undef PG8_BODYM
#undef PG8_MMA0
#undef PG8_SA
#undef PG8_SB
#undef PG8_STAGE
#undef PG8_STAGE2
#undef PG8_STAGEB
#undef PG8_STAGE_A
#undef PG8_GOFF
#undef PG8_LDA
#undef PG8_LDB
#undef PG8_MMA
#undef PG8_WAIT_V
#undef PG8_WAIT_L
#undef PG8_BAR
#undef PG8_SCHED
}
}

template <bool B16_> struct PbPlainT : pg8::StaticOrder {
    const bf16* A; const bf16* Bt; int K;
    __device__ __forceinline__ const char* a_base(const pg8::Unit& u) const { return (const char*)(A + (size_t)u.pm * 256 * K); }
    __device__ __forceinline__ const char* b_base(const pg8::Unit& u) const { return (const char*)(Bt + (size_t)u.pn * 256 * K); }
    static constexpr bool GATHER = false, FP8 = false, B16 = B16_; LAS const unsigned* goff;
};
typedef PbPlainT<false> PbPlain;
constexpr int GOFF_OFF = 131072;
__device__ __forceinline__ int pair_token(int t, int r) { if (r < 128) return 128 * t + r; const int sp = 128 * t + r - 128; return sp == 0 ? 1024 : SEQ - sp; }
struct PbDft {
    const bf16* T; const bf16* ET; const bf16* OT; int K, G, c; LAS const unsigned* goff;
    static constexpr bool GATHER = false, FP8 = false, B16 = false;
    __device__ __forceinline__ bool next(int i, pg8::Unit& u) const { const int L = (i >> 1) * G + c; if (L >= 256) return false; u.pm = (L >> 6) + 4 * (i & 1); u.pn = L & 63; return true; }
    __device__ __forceinline__ const char* a_base(const pg8::Unit& u) const { return (const char*)(T + (size_t)u.pm * 256 * K); }
    __device__ __forceinline__ const char* b_base(const pg8::Unit& u) const { return (const char*)((u.pm < 4 ? ET : OT) + (size_t)u.pn * 256 * K); }
};

struct PbMoe1 {
    const unsigned char* H2; const unsigned char* WGU; LAS const unsigned* goff; int K, G, c;
    __device__ __forceinline__ bool next(int i, pg8::Unit& u) const { const int L = i * G + c; if (L >= NPAIR * 8) return false;
        const int e = L >> 8, w = L & 255, x = w & 7, j = w >> 3, b = (j >> 3) * 8 + x; u.pm = b * 16 + e; u.pn = j & 7; return true; }
    __device__ __forceinline__ const char* a_base(const pg8::Unit&) const { return (const char*)H2; }
    __device__ __forceinline__ const char* b_base(const pg8::Unit& u) const { return (const char*)(WGU + ((size_t)(u.pm & 15) * 2048 + u.pn * 256) * 1024); }
    static constexpr bool GATHER = true, FP8 = true, B16 = false;
};
struct PbMoe2 {
    const unsigned char* ACT; const unsigned char* WD; int K, G, c, half;
    __device__ __forceinline__ bool next(int i, pg8::Unit& u) const { const int L = i * G + c;
        if (half < 0) { if (L >= NPAIR * 4) return false;
            const int e = L >> 7, w = L & 127, x = w & 7, j = w >> 3, b = (j >> 2) * 8 + x; u.pm = b * 16 + e; u.pn = j & 3; return true; }
        if (L >= NPAIR * 2) return false;
        const int e = L >> 6, w = L & 63, x = w & 7, b = half * 16 + (w >> 5) * 8 + x; u.pm = b * 16 + e; u.pn = (w >> 3) & 3; return true; }
    __device__ __forceinline__ const char* a_base(const pg8::Unit& u) const { return (const char*)(ACT + (size_t)u.pm * 256 * 1024); }
    __device__ __forceinline__ const char* b_base(const pg8::Unit& u) const { return (const char*)(WD + ((size_t)(u.pm & 15) * 1024 + u.pn * 256) * 1024); }
    static constexpr bool GATHER = false, FP8 = true, B16 = true; LAS const unsigned* goff;
};
typedef f32x4 AccT[2][2][4][2];
__device__ __forceinline__ v4u pack8(const f32x4& a, const f32x4& b) { v4u w; w.x = pk2(a.x, a.y); w.y = pk2(a.z, a.w); w.z = pk2(b.x, b.y); w.w = pk2(b.z, b.w); return w; }
__device__ __forceinline__ v4u ror8(v4u v) { v4u r;
    r.x = (unsigned)__builtin_amdgcn_update_dpp(0, (int)v.x, 0x128, 0xf, 0xf, false); r.y = (unsigned)__builtin_amdgcn_update_dpp(0, (int)v.y, 0x128, 0xf, 0xf, false);
    r.z = (unsigned)__builtin_amdgcn_update_dpp(0, (int)v.z, 0x128, 0xf, 0xf, false); r.w = (unsigned)__builtin_amdgcn_update_dpp(0, (int)v.w, 0x128, 0xf, 0xf, false); return r; }
struct EpiInProj { LAS unsigned char* lds;
    __device__ __forceinline__ void operator()(const AccT& acc, const pg8::Unit& u, int wr, int wc, int fr, int fq, int) const {
        KArgs ka = kargs(); unsigned char* ws = ka->ws;
        bf16* ET = (bf16*)(ws + WS_ET); bf16* OT = (bf16*)(ws + WS_OT); float* U1024 = (float*)(ws + WS_U1024); const bf16* MAT = (const bf16*)(ws + WS_MAT); const bf16* MBT = (const bf16*)(ws + WS_MBT);
        bf16* Q = (bf16*)(ws + WS_Q); bf16* Kb = (bf16*)(ws + WS_K); bf16* V = (bf16*)(ws + WS_V); const float* qg = ka->in[I_QG]; const float* kg = ka->in[I_KG];
        const int b = u.pm >> 3, t = u.pm & 7;
        if (u.pn < 2) {
            const int gg = 4 * u.pn + wc;
            const bf16* ma = MAT + gg * 4096 + fr * 64 + 8 * fq; const bf16* mb = MBT + gg * 4096 + fr * 64 + 8 * fq;
            bf16x8 fa[4][2], fb[4][2];
#pragma unroll
            for (int db = 0; db < 4; ++db) { fa[db][0] = *(const bf16x8*)(ma + db * 1024); fa[db][1] = *(const bf16x8*)(ma + db * 1024 + 32); fb[db][0] = *(const bf16x8*)(mb + db * 1024); fb[db][1] = *(const bf16x8*)(mb + db * 1024 + 32); }
            LAS unsigned short* tile = (LAS unsigned short*)(lds + GOFF_OFF + 8192 + (wr * 4 + wc) * 1024);
            const int l64 = fr + 16 * fq, dd = l64 >> 2, chn = l64 & 3;
#pragma unroll
            for (int mp = 0; mp < 2; ++mp) {
                bf16x8 ef[2][2], of[2][2], uf[2];
#pragma unroll
                for (int mm = 0; mm < 2; ++mm) { const int m = 2 * mp + mm; const bool tok0 = (t == 0 && wr == 0 && m == 0 && fr == 0);
#pragma unroll
                    for (int bj = 0; bj < 2; ++bj) { f32x4 e0 = acc[0][bj][m][0] + acc[1][bj][m][0], e1 = acc[0][bj][m][1] + acc[1][bj][m][1], o0 = acc[0][bj][m][0] - acc[1][bj][m][0], o1 = acc[0][bj][m][1] - acc[1][bj][m][1];
                        if (tok0) { e0 = acc[0][bj][m][0]; e1 = acc[0][bj][m][1]; o0 = (f32x4){0.f, 0.f, 0.f, 0.f}; o1 = o0; }
                        ef[mm][bj] = __builtin_bit_cast(bf16x8, pack8(e0, e1)); of[mm][bj] = __builtin_bit_cast(bf16x8, pack8(o0, o1));
                        if (m == 0) uf[bj] = __builtin_bit_cast(bf16x8, pack8(acc[1][bj][0][0], acc[1][bj][0][1])); } }
#pragma unroll
                for (int db = 0; db < 4; ++db) {
                    f32x4 em[2], om[2];
#pragma unroll
                    for (int mm = 0; mm < 2; ++mm) { em[mm] = (f32x4){0.f, 0.f, 0.f, 0.f}; om[mm] = em[mm];
                        em[mm] = __builtin_amdgcn_mfma_f32_16x16x32_bf16(fa[db][0], ef[mm][0], em[mm], 0, 0, 0); em[mm] = __builtin_amdgcn_mfma_f32_16x16x32_bf16(fa[db][1], ef[mm][1], em[mm], 0, 0, 0);
                        om[mm] = __builtin_amdgcn_mfma_f32_16x16x32_bf16(fb[db][0], of[mm][0], om[mm], 0, 0, 0); om[mm] = __builtin_amdgcn_mfma_f32_16x16x32_bf16(fb[db][1], of[mm][1], om[mm], 0, 0, 0); }
                    const unsigned o = (unsigned)(((unsigned)b * 512u + gg * 64 + 16 * db + dd) * 1024u + 128 * t + wr * 64 + 32 * mp + 8 * chn);
                    LAS unsigned short* tw = tile + (4 * fq) * 32 + fr;
                    tw[0] = (unsigned short)f2bf(em[0].x); tw[32] = (unsigned short)f2bf(em[0].y); tw[64] = (unsigned short)f2bf(em[0].z); tw[96] = (unsigned short)f2bf(em[0].w);
                    tw[16] = (unsigned short)f2bf(em[1].x); tw[48] = (unsigned short)f2bf(em[1].y); tw[80] = (unsigned short)f2bf(em[1].z); tw[112] = (unsigned short)f2bf(em[1].w);
                    asm volatile("" ::: "memory");
                    { const v4u ve = *(const LAS v4u*)(tile + dd * 32 + 8 * chn); asm volatile("" ::: "memory"); __builtin_nontemporal_store(ve, (v4u*)(ET + o)); }
                    tw[0] = (unsigned short)f2bf(om[0].x); tw[32] = (unsigned short)f2bf(om[0].y); tw[64] = (unsigned short)f2bf(om[0].z); tw[96] = (unsigned short)f2bf(om[0].w);
                    tw[16] = (unsigned short)f2bf(om[1].x); tw[48] = (unsigned short)f2bf(om[1].y); tw[80] = (unsigned short)f2bf(om[1].z); tw[112] = (unsigned short)f2bf(om[1].w);
                    asm volatile("" ::: "memory");
                    { const v4u vo = *(const LAS v4u*)(tile + dd * 32 + 8 * chn); asm volatile("" ::: "memory"); __builtin_nontemporal_store(vo, (v4u*)(OT + o)); }
                    if (mp == 0 && t == 0 && wr == 0) {
                        f32x4 um = {0.f, 0.f, 0.f, 0.f};
                        um = __builtin_amdgcn_mfma_f32_16x16x32_bf16(fa[db][0], uf[0], um, 0, 0, 0); um = __builtin_amdgcn_mfma_f32_16x16x32_bf16(fa[db][1], uf[1], um, 0, 0, 0);
                        if (fr == 0) *(f32x4*)(U1024 + b * 512 + gg * 64 + 16 * db + 4 * fq) = um; }
                } }
        } else {
            const int hg = (u.pn - 2) * 4 + wc;
            const bool isq = hg < 8, isk = (hg >= 8 && hg < 10);
            const float* gain = isq ? qg : kg;
            f32x4 gv[2][2];
#pragma unroll
            for (int bj = 0; bj < 2; ++bj)
#pragma unroll
                for (int n = 0; n < 2; ++n) gv[bj][n] = *(const f32x4*)(gain + 32 * bj + 8 * fq + 4 * n);
            bf16* base; int ld, hoff;
            if (isq) { base = Q; ld = 512; hoff = hg * 64; } else if (isk) { base = Kb; ld = 128; hoff = (hg - 8) * 64; } else { base = V; ld = 128; hoff = (hg - 10) * 64; }
#pragma unroll
            for (int ai = 0; ai < 2; ++ai)
#pragma unroll
                for (int m = 0; m < 4; ++m) { f32x4 s4 = acc[ai][0][m][0] * acc[ai][0][m][0];
                    s4 = acc[ai][0][m][1] * acc[ai][0][m][1] + s4; s4 = acc[ai][1][m][0] * acc[ai][1][m][0] + s4; s4 = acc[ai][1][m][1] * acc[ai][1][m][1] + s4;
                    float ss = (s4.x + s4.y) + (s4.z + s4.w);
                    ss += __shfl_xor(ss, 16); ss += __shfl_xor(ss, 32);
                    const float rs = (isq || isk) ? __builtin_amdgcn_rsqf(ss * (1.f / 64.f) + EPS) : 1.f;
                    v4u pc[2];
#pragma unroll
                    for (int bj = 0; bj < 2; ++bj) { f32x4 v0 = acc[ai][bj][m][0] * rs, v1 = acc[ai][bj][m][1] * rs; if (isq || isk) { v0 = v0 * gv[bj][0]; v1 = v1 * gv[bj][1]; } pc[bj] = pack8(v0, v1); }
                    const bool lo = fr < 8; const v4u rcv = ror8(lo ? pc[1] : pc[0]);
                    const int rbase = ai * 128 + wr * 64 + m * 16 + (fr & 7);
                    const int tokA = b * SEQ + pair_token(t, rbase), tokB = b * SEQ + pair_token(t, rbase + 8);
                    bf16* pA = base + (unsigned)((unsigned)tokA * ld + hoff + 8 * fq + (lo ? 0 : 32)); bf16* pB = base + (unsigned)((unsigned)tokB * ld + hoff + 8 * fq + (lo ? 0 : 32));
                    const v4u wA = lo ? pc[0] : rcv, wB = lo ? rcv : pc[1];
                    __builtin_nontemporal_store(wA, (v4u*)pA); __builtin_nontemporal_store(wB, (v4u*)pB); }
        }
    }
};
struct EpiDft {
    __device__ __forceinline__ void operator()(const AccT& acc, const pg8::Unit& u, int wr, int wc, int fr, int fq, int) const {
        KArgs ka = kargs(); unsigned char* ws = ka->ws; bf16* Y = (bf16*)(ws + WS_Y); bf16* PA = (bf16*)(ws + WS_PA);   const float* U1024 = (const float*)(ws + WS_U1024); const float* bfv = ka->in[I_BF];
        const int b = u.pn >> 1; const bool cosr = u.pm < 4; const float sgn = (fr & 1) ? -1.f : 1.f;
        bf16* pa = PA + (size_t)((u.pm & 3) * 64 + u.pn) * 65536;
        bf16* yb = Y + (unsigned)((unsigned)b * SEQ * KOUT);
#pragma unroll
        for (int bj = 0; bj < 2; ++bj) { const int cl = bj * 128 + wc * 32 + 8 * fq, ch = (u.pn & 1) * 256 + cl;
            f32x4 ua, ub;
            if (cosr) { ua = *(const f32x4*)(U1024 + b * 512 + ch) * sgn; ub = *(const f32x4*)(U1024 + b * 512 + ch + 4) * sgn; }
            else { ua = *(const f32x4*)(bfv + ch); ub = *(const f32x4*)(bfv + ch + 4); }
#pragma unroll
            for (int ai = 0; ai < 2; ++ai)
#pragma unroll
                for (int m = 0; m < 4; ++m) { const int rl = ai * 128 + wr * 64 + m * 16 + fr, k = (u.pm & 3) * 256 + rl;
                    bf16* pp = pa + rl * 256 + cl;
                    if (cosr) { *(v4u*)pp = pack8(acc[ai][bj][m][0] + ua, acc[ai][bj][m][1] + ub); }
                    else { const v4u pw = *(const v4u*)pp;
                        const f32x4 p0 = (f32x4){bf2f(pw.x & 0xffffu), bf2f(pw.x >> 16), bf2f(pw.y & 0xffffu), bf2f(pw.y >> 16)} + ua, p1 = (f32x4){bf2f(pw.z & 0xffffu), bf2f(pw.z >> 16), bf2f(pw.w & 0xffffu), bf2f(pw.w >> 16)} + ub;
                        *(v4u*)(yb + (unsigned)(k * KOUT + ch)) = pack8(p0 + acc[ai][bj][m][0], p1 + acc[ai][bj][m][1]);
                        if (k > 0) *(v4u*)(yb + (unsigned)((SEQ - k) * KOUT + ch)) = pack8(p0 - acc[ai][bj][m][0], p1 - acc[ai][bj][m][1]); } } }
    }
};
struct EpiOut {
    __device__ __forceinline__ void operator()(const AccT& acc, const pg8::Unit& u, int wr, int wc, int fr, int fq, int) const {
        KArgs ka = kargs(); unsigned char* ws = ka->ws; bf16* DELTA = (bf16*)(ws + WS_DELTA);
        const bool lo = fr < 8;
        const int rowb = u.pm * 256 + wr * 64, b = rowb / SEQ, col0 = u.pn * 256 + wc * 64 + 16 * fq;
        const float* g1p = (const float*)(ws + WS_MOD) + b * NADA + 2 * DM + col0;
        const f32x4 g0 = *(const f32x4*)g1p, g1 = *(const f32x4*)(g1p + 4), g2 = *(const f32x4*)(g1p + 8), g3 = *(const f32x4*)(g1p + 12);
        bf16* base = DELTA + (unsigned)(rowb + (fr & 7)) * DM + col0 + (lo ? 0 : 8);
#pragma unroll
        for (int ai = 0; ai < 2; ++ai)
#pragma unroll
            for (int m = 0; m < 4; ++m) {
                const v4u pa = pack8(g0 * acc[ai][0][m][0], g1 * acc[ai][0][m][1]), pb = pack8(g2 * acc[ai][1][m][0], g3 * acc[ai][1][m][1]);
                const v4u snd = lo ? pb : pa, rcv = ror8(snd);
                bf16* rp = base + (unsigned)(ai * 128 + m * 16) * DM;
                __builtin_nontemporal_store(lo ? pa : rcv, (v4u*)rp);
                __builtin_nontemporal_store(lo ? rcv : pb, (v4u*)(rp + 8 * DM)); }
    }
};
__device__ __forceinline__ float silu_mul(float g, float u) { return g * u * __builtin_amdgcn_rcpf(1.f + __builtin_amdgcn_exp2f(-LOG2E * g)); }
struct EpiSwiGLU { static constexpr bool SPLIT = false;
    __device__ __forceinline__ void operator()(const AccT& acc, const pg8::Unit& u, int wr, int wc, int fr, int fq, int) const {
        unsigned char* ACT = kargs()->ws + WS_ACT;
#pragma unroll
        for (int ai = 0; ai < 2; ++ai)
#pragma unroll
            for (int mp = 0; mp < 2; ++mp) { v2u w[2];
#pragma unroll
                for (int mm = 0; mm < 2; ++mm) { const int m = 2 * mp + mm; f32x4 o[2];
                    typedef float f2v __attribute__((ext_vector_type(2)));
#pragma unroll
                    for (int n = 0; n < 2; ++n) {
#pragma unroll
                        for (int jp = 0; jp < 2; ++jp) { const f2v ag = {acc[ai][0][m][n][2 * jp], acc[ai][0][m][n][2 * jp + 1]}, au = {acc[ai][1][m][n][2 * jp], acc[ai][1][m][n][2 * jp + 1]};
                            const f2v t = ag * (f2v){-LOG2E * W8I, -LOG2E * W8I}; f2v d = {__builtin_amdgcn_exp2f(t.x), __builtin_amdgcn_exp2f(t.y)}; d = d + (f2v){1.f, 1.f};
                            const f2v r = {__builtin_amdgcn_rcpf(d.x), __builtin_amdgcn_rcpf(d.y)};
                            const f2v ov = (ag * au) * (r * (f2v){W8I * W8I, W8I * W8I}); o[n][2 * jp] = ov.x; o[n][2 * jp + 1] = ov.y; } }
                    w[mm].x = pk4_fp8(o[0].x, o[0].y, o[0].z, o[0].w); w[mm].y = pk4_fp8(o[1].x, o[1].y, o[1].z, o[1].w); }
                const v2u sx = __builtin_amdgcn_permlane16_swap(w[0].x, w[1].x, false, false), sy = __builtin_amdgcn_permlane16_swap(w[0].y, w[1].y, false, false);
                v4u ov; ov.x = sx[0]; ov.y = sy[0]; ov.z = sx[1]; ov.w = sy[1];
                unsigned char* rowp = ACT + (unsigned)(((unsigned)u.pm * 256u + (unsigned)(ai * 128 + wr * 64 + (2 * mp + (fq & 1)) * 16 + fr)) * DEXP + u.pn * 128 + wc * 32 + 16 * (fq >> 1));
                __builtin_nontemporal_store(ov, (v4u*)rowp); }
    }
};
struct EpiY { static constexpr bool SPLIT = false; LAS const float* gate;
    __device__ __forceinline__ void operator()(const AccT& acc, const pg8::Unit& u, int wr, int wc, int fr, int fq, int ui) const {
        unsigned char* YB = kargs()->ws + WS_YB;
#pragma unroll
        for (int ai = 0; ai < 2; ++ai)
#pragma unroll
            for (int m = 0; m < 4; ++m) { const int rl = ai * 128 + wr * 64 + m * 16 + fr; const float gt = gate[ui * 256 + rl]; unsigned char* rowp = YB + (unsigned)(((unsigned)u.pm * 256u + (unsigned)rl) * DM + u.pn * 256 + wc * 64 + 16 * fq);
                const f32x4 v0 = acc[ai][0][m][0] * gt, v1 = acc[ai][0][m][1] * gt, v2 = acc[ai][1][m][0] * gt, v3 = acc[ai][1][m][1] * gt; v4u w;
                w.x = pk4_fp8(v0.x, v0.y, v0.z, v0.w); w.y = pk4_fp8(v1.x, v1.y, v1.z, v1.w); w.z = pk4_fp8(v2.x, v2.y, v2.z, v2.w); w.w = pk4_fp8(v3.x, v3.y, v3.z, v3.w);
                *(v4u*)rowp = w; }
    }
};

typedef float f32x16 __attribute__((ext_vector_type(16)));
constexpr int AT_KL = 0, AT_KSTRIDE = 144;
constexpr int AT_VT = 384 * 144, AT_VSTRIDE = 776;
constexpr int AT_TB = AT_VT + 64 * 776;
__device__ __forceinline__ void attn_phase(KArgs a, LAS unsigned char* lds, int tid, int wave, int lane, int G) {
    const bf16* Q = (const bf16*)(a->ws + WS_Q); const bf16* Kb = (const bf16*)(a->ws + WS_K); const bf16* V = (const bf16*)(a->ws + WS_V); bf16* Y = (bf16*)(a->ws + WS_Y);
    LAS float* TB = (LAS float*)(lds + AT_TB);
    for (int i = tid; i < 8 * 257; i += NTHR) { const int h = i / 257, ii = i % 257; TB[h * 260 + ii] = a->in[I_RELB][t5_bucket(ii - 128) * 8 + h] * 8.f; }
    const int l31 = lane & 31, hh = lane >> 5;
    const float c1 = 0.125f * LOG2E;
    for (int it = blockIdx.x; it < NB * 2 * 4; it += G) {
        const int b = it >> 3, kh = (it >> 2) & 1, qs0 = (it & 3) * 512;
        __syncthreads();
        for (int c = tid; c < 3072; c += NTHR) { const int r = c >> 3, ch = c & 7, key = qs0 - 128 + r; v4u val = {0u, 0u, 0u, 0u};
            if (key >= 0 && key < SEQ) val = *(const v4u*)(Kb + ((size_t)b * SEQ + key) * 128 + kh * 64 + ch * 8);
            *(LAS v4u*)(lds + AT_KL + r * AT_KSTRIDE + ch * 16) = val; }
        for (int c = tid; c < 1536; c += NTHR) { const int kp = c % 192, cd = c / 192, r = 2 * kp, key = qs0 - 128 + r; v4u v0 = {0u, 0u, 0u, 0u}, v1 = {0u, 0u, 0u, 0u};
            if (key >= 0 && key < SEQ) { const bf16* vp = V + ((size_t)b * SEQ + key) * 128 + kh * 64 + cd * 8; v0 = *(const v4u*)vp; v1 = *(const v4u*)(vp + 128); }
            const unsigned w0[4] = {v0.x, v0.y, v0.z, v0.w}, w1[4] = {v1.x, v1.y, v1.z, v1.w};
#pragma unroll
            for (int j = 0; j < 4; ++j) {
                *(LAS unsigned*)(lds + AT_VT + (8 * cd + 2 * j) * AT_VSTRIDE + r * 2) = (w0[j] & 0xffffu) | (w1[j] << 16);
                *(LAS unsigned*)(lds + AT_VT + (8 * cd + 2 * j + 1) * AT_VSTRIDE + r * 2) = (w0[j] >> 16) | (w1[j] & 0xffff0000u); } }
        __syncthreads();
      const int r4 = wave >> 1, half = wave & 1, hq = kh * 4 + r4;
      bf16x8 qf[2][4];
#pragma unroll
      for (int j = 0; j < 2; ++j)
#pragma unroll
          for (int ks = 0; ks < 4; ++ks) qf[j][ks] = *(const bf16x8*)(Q + ((size_t)b * SEQ + qs0 + 64 * half + 32 * j + l31) * 512 + hq * 64 + 16 * ks + 8 * hh);
      for (int bi = 0; bi < 4; ++bi) {
        const int qs = qs0 + 128 * bi;
        const int nkey0 = qs0 + 256 + 128 * bi;
        v4u pk0 = {0u, 0u, 0u, 0u}, pk1 = pk0, pv0 = pk0, pv1 = pk0;
        if (bi < 3 && nkey0 < SEQ) { const bf16* kp_ = Kb + ((size_t)b * SEQ + nkey0 + (tid >> 3)) * 128 + kh * 64 + (tid & 7) * 8; pk0 = *(const v4u*)kp_; pk1 = *(const v4u*)(kp_ + 64 * 128);
            const bf16* vp_ = V + ((size_t)b * SEQ + nkey0 + 2 * (tid & 63)) * 128 + kh * 64 + (tid >> 6) * 8; pv0 = *(const v4u*)vp_; pv1 = *(const v4u*)(vp_ + 128); }
        const int q0 = qs + 64 * half;
        float mrun[2], lrun[2]; f32x16 O[2][2];
        { const float sk = a->in[I_SINK][hq] * LOG2E; mrun[0] = sk; mrun[1] = sk; lrun[0] = hh == 0 ? 1.f : 0.f; lrun[1] = lrun[0]; }
#pragma unroll
        for (int d = 0; d < 2; ++d)
#pragma unroll
            for (int j = 0; j < 2; ++j)
#pragma unroll
                for (int i = 0; i < 16; ++i) O[d][j][i] = 0.f;
        const LAS float* tbh = TB + hq * 260;
        for (int kk = 0; kk < 10; ++kk) {
            const int key0 = q0 - 128 + 32 * kk;
            if (key0 + 31 < 0 || key0 >= SEQ) continue;
            const int rel = 128 * bi + 64 * half + 32 * kk, lrow = ((rel >> 7) % 3) * 128 + (rel & 127);
            const bool edge = (key0 < 0) || (key0 + 31 >= SEQ);
            bf16x8 kf[4];
#pragma unroll
            for (int ks = 0; ks < 4; ++ks) kf[ks] = *(const LAS bf16x8*)(lds + AT_KL + (lrow + l31) * AT_KSTRIDE + (16 * ks + 8 * hh) * 2);
            bf16x8 pf[2][2]; bool live[2];
#pragma unroll
            for (int j = 0; j < 2; ++j) {
                const int dk = kk - j;
                live[j] = (dk >= 0 && dk <= 8);
                if (!live[j]) continue;
                f32x16 S;
                const int ib = 32 * dk - l31 + 4 * hh;
                const bool interior = (dk >= 1 && dk <= 7 && !edge);
                if (interior) { const LAS float* tp = tbh + ib;
#pragma unroll
                    for (int i = 0; i < 16; ++i) S[i] = tp[(i & 3) + 8 * (i >> 2)];
                } else { int ibm = ib; asm volatile("" : "+v"(ibm));
#pragma unroll
                    for (int i = 0; i < 16; ++i) { const int idx = ibm + (i & 3) + 8 * (i >> 2); S[i] = tbh[idx < 0 ? 0 : (idx > 256 ? 256 : idx)]; }
                }
#pragma unroll
                for (int ks = 0; ks < 4; ++ks) S = __builtin_amdgcn_mfma_f32_32x32x16_bf16(kf[ks], qf[j][ks], S, 0, 0, 0);
                if (!interior) { int ibm = ib, kb = key0 + 4 * hh; asm volatile("" : "+v"(ibm), "+v"(kb));
#pragma unroll
                    for (int i = 0; i < 16; ++i) { const int ro = (i & 3) + 8 * (i >> 2), idx = ibm + ro, key = kb + ro;
                        const bool valid = (idx >= 0) && (idx <= 256) && (key >= 0) && (key < SEQ); S[i] = valid ? S[i] : -INFINITY; }
                }
                float mx = fmaxf(fmaxf(S[0], S[1]), S[2]);
#pragma unroll
                for (int i = 3; i < 15; i += 2) mx = fmaxf(fmaxf(mx, S[i]), S[i + 1]);
                mx = fmaxf(mx, S[15]);
                mx = fmaxf(mx, __shfl_xor(mx, 32)) * c1;
                if (__any(mx > mrun[j] + 8.f)) {
                    const float mn = fmaxf(mrun[j], mx), al = __builtin_amdgcn_exp2f(mrun[j] - mn); mrun[j] = mn; lrun[j] *= al;
#pragma unroll
                    for (int d = 0; d < 2; ++d)
#pragma unroll
                        for (int i = 0; i < 16; ++i) O[d][j][i] *= al;
                }
                typedef float f2v __attribute__((ext_vector_type(2)));
                const f2v nm2 = {-mrun[j], -mrun[j]}, c2 = {c1, c1}; f2v rs2 = {0.f, 0.f};
#pragma unroll
                for (int i = 0; i < 16; i += 2) { f2v t2 = {S[i], S[i + 1]}; t2 = t2 * c2 + nm2; f2v p2; p2.x = __builtin_amdgcn_exp2f(t2.x); p2.y = __builtin_amdgcn_exp2f(t2.y); S[i] = p2.x; S[i + 1] = p2.y; rs2 += p2; }
                lrun[j] += rs2.x + rs2.y;
#pragma unroll
                for (int s2 = 0; s2 < 2; ++s2) { v4u w; w.x = pk2(S[8 * s2], S[8 * s2 + 1]); w.y = pk2(S[8 * s2 + 2], S[8 * s2 + 3]); w.z = pk2(S[8 * s2 + 4], S[8 * s2 + 5]); w.w = pk2(S[8 * s2 + 6], S[8 * s2 + 7]); pf[j][s2] = __builtin_bit_cast(bf16x8, w); }
            }
#pragma unroll
            for (int d = 0; d < 2; ++d)
#pragma unroll
                for (int s2 = 0; s2 < 2; ++s2) { const LAS unsigned char* vp = lds + AT_VT + (32 * d + l31) * AT_VSTRIDE + (lrow + 16 * s2 + 4 * hh) * 2;
                    const v2u lo = *(const LAS v2u*)vp, hi = *(const LAS v2u*)(vp + 16); v4u w; w.x = lo.x; w.y = lo.y; w.z = hi.x; w.w = hi.y; const bf16x8 vf = __builtin_bit_cast(bf16x8, w);
#pragma unroll
                    for (int j = 0; j < 2; ++j) if (live[j]) O[d][j] = __builtin_amdgcn_mfma_f32_32x32x16_bf16(vf, pf[j][s2], O[d][j], 0, 0, 0); }
        }
        if (bi < 3) {
#pragma unroll
            for (int j = 0; j < 2; ++j)
#pragma unroll
                for (int ks = 0; ks < 4; ++ks) qf[j][ks] = *(const bf16x8*)(Q + ((size_t)b * SEQ + q0 + 128 + 32 * j + l31) * 512 + hq * 64 + 16 * ks + 8 * hh); }
#pragma unroll
        for (int j = 0; j < 2; ++j) { const float lt = lrun[j] + __shfl_xor(lrun[j], 32); const float inv = 1.f / lt;
            bf16* yp = Y + ((size_t)b * SEQ + q0 + 32 * j + l31) * KOUT + 512 + hq * 64 + 8 * hh;
#pragma unroll
            for (int d = 0; d < 2; ++d)
#pragma unroll
                for (int gp = 0; gp < 2; ++gp) { v2u w0, w1;
                    w0.x = pk2(O[d][j][8 * gp] * inv, O[d][j][8 * gp + 1] * inv); w0.y = pk2(O[d][j][8 * gp + 2] * inv, O[d][j][8 * gp + 3] * inv);
                    w1.x = pk2(O[d][j][8 * gp + 4] * inv, O[d][j][8 * gp + 5] * inv); w1.y = pk2(O[d][j][8 * gp + 6] * inv, O[d][j][8 * gp + 7] * inv);
                    const v2u sx = __builtin_amdgcn_permlane32_swap(w0.x, w1.x, false, false), sy = __builtin_amdgcn_permlane32_swap(w0.y, w1.y, false, false);
                    v4u ov; ov.x = sx[0]; ov.y = sy[0]; ov.z = sx[1]; ov.w = sy[1];
                    *(v4u*)(yp + 32 * d + 16 * gp) = ov; } }
        if (bi < 3) {
            __syncthreads();
            const int slot = bi % 3, r0 = slot * 128 + (tid >> 3);
            *(LAS v4u*)(lds + AT_KL + r0 * AT_KSTRIDE + (tid & 7) * 16) = pk0; *(LAS v4u*)(lds + AT_KL + (r0 + 64) * AT_KSTRIDE + (tid & 7) * 16) = pk1;
            const int cd = tid >> 6, rr = slot * 128 + 2 * (tid & 63); const unsigned w0[4] = {pv0.x, pv0.y, pv0.z, pv0.w}, w1[4] = {pv1.x, pv1.y, pv1.z, pv1.w};
#pragma unroll
            for (int j = 0; j < 4; ++j) {
                *(LAS unsigned*)(lds + AT_VT + (8 * cd + 2 * j) * AT_VSTRIDE + rr * 2) = (w0[j] & 0xffffu) | (w1[j] << 16);
                *(LAS unsigned*)(lds + AT_VT + (8 * cd + 2 * j + 1) * AT_VSTRIDE + rr * 2) = (w0[j] >> 16) | (w1[j] & 0xffff0000u); }
            __syncthreads();
        }
      }
    }
    __syncthreads();
}

__device__ __forceinline__ void ph2_inproj(KArgs args, LAS unsigned char* lds, int tid, int G, int bx, int wave) {
    unsigned char* ws = args->ws;
    PbPlain P; P.init(MTOK, NPROJ, G, bx); P.A = (const bf16*)(ws + WS_H); P.Bt = (const bf16*)(ws + WS_WIN); P.K = DM; P.goff = nullptr;
    EpiInProj E{lds};
    pg8::gemm_phase(lds, P, E, wave);
}
__device__ __forceinline__ void ph3_dft(KArgs args, LAS unsigned char* lds, int G, int bx, int wave, int lane, int vcu) {
    unsigned char* ws = args->ws;
    PbDft P; P.T = (const bf16*)(ws + WS_T); P.ET = (const bf16*)(ws + WS_ET); P.OT = (const bf16*)(ws + WS_OT); P.K = 1024; P.G = G; P.c = bx; P.goff = nullptr;
    EpiDft E;
    pg8::gemm_phase(lds, P, E, wave);
    { const bf16* ET = (const bf16*)(ws + WS_ET); const float* U1024 = (const float*)(ws + WS_U1024); const float* bfv = args->in[I_BF]; bf16* Y = (bf16*)(ws + WS_Y);
      const int gw = vcu * NWAVES + wave, NGW = G * NWAVES;
      for (int row0 = gw * 8; row0 < NB * 512; row0 += NGW * 8) {
          v4u d[8][2]; float sacc[8];
#pragma unroll
          for (int q = 0; q < 8; ++q) ld_row_bf(ET + (size_t)(row0 + q) * 1024, lane, d[q]);
#pragma unroll
          for (int q = 0; q < 8; ++q) { sacc[q] = 0.f;
#pragma unroll
              for (int h = 0; h < 2; ++h) sacc[q] += (bf2f(d[q][h].x & 0xffffu) - bf2f(d[q][h].x >> 16)) + (bf2f(d[q][h].y & 0xffffu) - bf2f(d[q][h].y >> 16)) + (bf2f(d[q][h].z & 0xffffu) - bf2f(d[q][h].z >> 16)) + (bf2f(d[q][h].w & 0xffffu) - bf2f(d[q][h].w >> 16)); }
#pragma unroll
          for (int o = 1; o < 64; o <<= 1) {
#pragma unroll
              for (int q = 0; q < 8; ++q) sacc[q] += __shfl_xor(sacc[q], o); }
          float mine = sacc[0];
#pragma unroll
          for (int q = 1; q < 8; ++q) mine = (lane == q) ? sacc[q] : mine;
          if (lane < 8) { const int row = row0 + lane; Y[((size_t)(row >> 9) * SEQ + 1024) * KOUT + (row & 511)] = (bf16)f2bf(mine + U1024[row] + bfv[row & 511]); } } }
}
__device__ __forceinline__ void ph4_out(KArgs args, LAS unsigned char* lds, int G, int bx, int wave) {
    unsigned char* ws = args->ws;
    PbPlainT<true> P; P.init(MTOK, DM, G, bx); P.A = (const bf16*)(ws + WS_Y); P.Bt = (const bf16*)(ws + WS_WOUT); P.K = KOUT;
    EpiOut E;
    pg8::gemm_phase(lds, P, E, wave);
}
__device__ __forceinline__ void ph7_moe1(KArgs args, LAS unsigned char* lds, int tid, int G, int bx, int wave) {
    unsigned char* ws = args->ws;
    PbMoe1 P; P.H2 = ws + WS_H2; P.WGU = ws + WS_WGU; P.goff = (LAS const unsigned*)(lds + GOFF_OFF); P.K = DM; P.G = G; P.c = bx;
    { const int* IDX = (const int*)(ws + WS_IDX); LAS unsigned* go = (LAS unsigned*)(lds + GOFF_OFF); pg8::Unit u;
      for (int i = 0; i < 16 && P.next(i, u); ++i) for (int r = tid; r < 256; r += NTHR) go[i * 256 + r] = (unsigned)(((u.pm >> 4) * SEQ + IDX[u.pm * CAP + r]) * DM);
      __syncthreads(); }
    EpiSwiGLU E;
    pg8::gemm_phase(lds, P, E, wave);
}
__device__ __forceinline__ void ph8_moe2(KArgs args, LAS unsigned char* lds, int G, int bx, int wave, int half) {
    unsigned char* ws = args->ws;
    PbMoe2 P; P.ACT = ws + WS_ACT; P.WD = ws + WS_WD; P.goff = nullptr; P.K = DEXP; P.G = G; P.c = bx; P.half = half;
    { const float* GATE = (const float*)(ws + WS_GATE); LAS float* gl = (LAS float*)(lds + GOFF_OFF); pg8::Unit u;
      for (int i = 0; i < 8 && P.next(i, u); ++i) for (int r = wave * 64 + lane_fresh(); r < 256; r += NTHR) gl[i * 256 + r] = GATE[u.pm * CAP + r];
      __syncthreads(); }
    EpiY E{(LAS const float*)(lds + GOFF_OFF)};
    pg8::gemm_phase(lds, P, E, wave);
}

constexpr int LDSCTL_OFF = 147456;
constexpr int CW_BAR = 4096;
__global__ void __launch_bounds__(NTHR, 2) mega(Args args) {
    extern __shared__ __attribute__((aligned(16))) unsigned char lds_raw[];
    LAS unsigned char* lds = (LAS unsigned char*)lds_raw;
    const int wave = __builtin_amdgcn_readfirstlane(threadIdx.x >> 6);
#define LANE lane_fresh()
#define TID (wave * 64 + lane_fresh())
    const int G = gridDim.x; const int bx = blockIdx.x; const int vcu = (G % 8 == 0) ? (bx % 8) * (G / 8) + bx / 8 : bx;
    const int lo = args.ph_lo, hi = args.ph_hi;
    unsigned char* ws = args.ws;
    for (int u = TID; u < 128; u += NTHR) ((LAS unsigned*)(lds + LDSCTL_OFF))[u] = 0u;
    __syncthreads();
    XcdBarrier bar; bar.bar = (unsigned*)(ws + WS_CTL) + CW_BAR; bar.x = 0; bar.st = nullptr;
    if (hi - lo > 1) bar = xcd_barrier_post((unsigned*)(ws + WS_CTL) + CW_BAR, (volatile LAS unsigned*)(lds + LDSCTL_OFF), wave);
#ifndef PROBE_DUP
#define PROBE_DUP -1
#endif
#define IN(k) (lo <= (k) && (k) < hi)
#define SEAM(k) do { if (IN(k) && IN((k) + 1)) xcd_barrier(bar, wave); } while (0)
#define PHASE(k, ...) do { if (IN(k)) { __VA_ARGS__; if (PROBE_DUP == (k)) { xcd_barrier(bar, wave); __VA_ARGS__; } } SEAM(k); } while (0)
    PHASE(0, p0_mod(kargs(), lds, TID, G); p0_maps(kargs(), lds, TID, G); p0_rest(kargs(), lds, TID, wave, LANE, vcu, G));
    PHASE(1, p1_h(kargs(), wave, LANE, vcu, G));
    PHASE(2, ph2_inproj(kargs(), lds, TID, G, bx, wave));
    PHASE(3, if (kargs()->li != 2) ph3_dft(kargs(), lds, G, bx, wave, LANE, vcu); if (kargs()->li != 1) attn_phase(kargs(), lds, TID, wave, LANE, G));
    PHASE(4, ph4_out(kargs(), lds, G, bx, wave));
    PHASE(5, p5_router(kargs(), lds, TID, wave, LANE, vcu, G));
    PHASE(6, p6_topk(kargs(), lds, TID, G));
    PHASE(7, ph7_moe1(kargs(), lds, TID, G, bx, wave));
    PHASE(8, ph8_moe2(kargs(), lds, G, bx, wave, -1));
    PHASE(9, p9_combine(kargs(), LANE, 0, MTOK / 4, vcu * NWAVES + wave, G * NWAVES));
#undef PHASE
#undef IN
#undef SEAM
}

#ifndef MK_CUTS
#define MK_CUTS 1
#endif
extern "C" void kernel_launch(void* const* d_in, const int* in_sizes, int n_in, void* d_out, int out_size, void* d_ws, size_t ws_size, hipStream_t stream) {
    static int grid = 0;
    if (grid == 0) {
        if (n_in != 18 || in_sizes[0] != MTOK * DM || out_size != MTOK * DM || ws_size < WS_END) { fprintf(stderr, "kernel_launch: unexpected shapes (n_in %d, in0 %d, out %d, ws %zu)\n", n_in, n_in > 0 ? in_sizes[0] : -1, out_size, ws_size); grid = -1; return; }
        int dev = 0, cus = 0;
        if (hipGetDevice(&dev) != hipSuccess || hipDeviceGetAttribute(&cus, hipDeviceAttributeMultiprocessorCount, dev) != hipSuccess) { grid = -1; return; }
        if (hipFuncSetAttribute((const void*)mega, hipFuncAttributeMaxDynamicSharedMemorySize, LDS_BYTES) != hipSuccess) { fprintf(stderr, "kernel_launch: hipFuncSetAttribute failed\n"); grid = -1; return; }
        (void)hipGetLastError();
        grid = cus;
    }
    if (grid < 0) return;
    (void)hipMemsetAsync((char*)d_ws + WS_CTL, 0, 65536, stream);
    Args a{};
    for (int i = 0; i < 18; ++i) a.in[i] = (const float*)d_in[i];
    a.out = (float*)d_out; a.ws = (unsigned char*)d_ws;
    auto run = [&](int lo, int hi) { Args b = a; b.ph_lo = lo; b.ph_hi = hi; b.li = 0; hipLaunchKernelGGL(mega, dim3(grid), dim3(NTHR), LDS_BYTES, stream, b); };
#ifndef PROBE_HOST_DUP
#define PROBE_HOST_DUP -1
#endif
    if (MK_CUTS == 1) run(0, 10);
    else for (int p = 0; p < 10; ++p) { run(p, p + 1);
        if (PROBE_HOST_DUP == p) run(p, p + 1);
        if (p == 3 && (PROBE_HOST_DUP == 31 || PROBE_HOST_DUP == 32)) { Args b = a; b.ph_lo = 3; b.ph_hi = 4; b.li = PROBE_HOST_DUP - 30; hipLaunchKernelGGL(mega, dim3(grid), dim3(NTHR), LDS_BYTES, stream, b); } }
}
```
